# Optimizing an MI355X kernel written in HIP

```python
import jax, jax.numpy as jnp
from jax import lax
import numpy as np

D_MODEL = 1024
BATCH = 2
SEQ = 8192
DEPTH = 1

GRID_W = 64
CTX_LEN = 256
CHUNK_A = 128
A_GROUPS = 4
D_A = D_MODEL
GLA_HEADS = 4
DK_TOT = D_MODEL // 2
DV_TOT = D_MODEL
DK = DK_TOT // GLA_HEADS
DV = DV_TOT // GLA_HEADS
GATE_RANK = 16
GATE_TAU = 16.0
GLA_CHUNK = 64
D_FF = 4 * D_MODEL
EPS = 1e-6
IN_COLS = 2 * D_A + 2 * DK_TOT + 2 * DV_TOT + 2 * GATE_RANK + 2 * D_MODEL

kernel_name = "hybrid_gmlp_gla_prefix_dit_block"


def rms_norm(x, g):
    xf = x.astype(jnp.float32)
    y = xf * lax.rsqrt(jnp.mean(xf * xf, -1, keepdims=True) + EPS)
    return (y * g.astype(jnp.float32)).astype(x.dtype)


def modulate(x, g, shift, scale):
    return rms_norm(x, g) * (1 + scale) + shift


def grid_pos_embed(n_tokens, dim, dtype):
    rows = n_tokens // GRID_W
    t = jnp.arange(rows * GRID_W)
    row = (t // GRID_W).astype(jnp.float32)
    col = (t % GRID_W).astype(jnp.float32)
    quarter = dim // 4
    freqs = 1.0 / (10000.0 ** (jnp.arange(quarter, dtype=jnp.float32) / quarter))

    def emb(p):
        a = p[:, None] * freqs[None, :]
        return jnp.concatenate([jnp.sin(a), jnp.cos(a)], -1)

    return jnp.concatenate([emb(row), emb(col)], -1).astype(dtype)


def chunk_mlp(u, v, ln_g, ln_b, w_s, b_s):
    B, L, _ = v.shape
    vf = v.astype(jnp.float32)
    mu = jnp.mean(vf, -1, keepdims=True)
    var = jnp.mean(jnp.square(vf - mu), -1, keepdims=True)
    vn = ((vf - mu) * lax.rsqrt(var + EPS) * ln_g.astype(jnp.float32) + ln_b.astype(jnp.float32)).astype(v.dtype)
    vc = vn.reshape(B, L // CHUNK_A, CHUNK_A, A_GROUPS, D_A // A_GROUPS)
    s = jnp.einsum('gpq,bnqgc->bnpgc', w_s, vc) + b_s.T[None, None, :, :, None]
    return u * s.reshape(B, L, D_A)


def gla_scan(q, k, v, logdecay, s0):
    B, L, H, _ = q.shape
    n = L // GLA_CHUNK

    def to_chunks(a):
        return a.reshape(B, n, GLA_CHUNK, H, a.shape[-1]).transpose(1, 0, 3, 2, 4)

    mask = jnp.tril(jnp.ones((GLA_CHUNK, GLA_CHUNK), dtype=bool))[:, :, None]

    def body(S, inp):
        qc, kc, vc, gc = inp
        b = jnp.cumsum(gc, axis=2)
        diff = b[:, :, :, None, :] - b[:, :, None, :, :]
        dec = jnp.exp(jnp.where(mask, diff, -jnp.inf))
        attn = jnp.einsum('bhik,bhjk,bhijk->bhij', qc, kc, dec)
        o = jnp.einsum('bhij,bhjv->bhiv', attn, vc) + jnp.einsum('bhik,bhkv->bhiv', qc * jnp.exp(b), S)
        b_last = b[:, :, -1]
        S_new = jnp.exp(b_last)[..., None] * S + jnp.einsum(
            'bhjk,bhjv->bhkv', kc * jnp.exp(b_last[:, :, None, :] - b), vc)
        return S_new, o

    S_fin, o = lax.scan(body, s0, (to_chunks(q), to_chunks(k), to_chunks(v), to_chunks(logdecay)))
    return o.transpose(1, 0, 3, 2, 4).reshape(B, L, H, v.shape[-1]), S_fin


def bidir_gla(q, k, v, lg_f, lg_b, s_f0, s_b0):
    o_f, s_f = gla_scan(q, k, v, lg_f, s_f0)
    flip = lambda a: a[:, ::-1]
    o_b, s_b = gla_scan(flip(q), flip(k), flip(v), flip(lg_b), s_b0)
    return o_f + flip(o_b), s_f, s_b


def mixer(h, s_f0, s_b0, lp, with_output):
    B, T, _ = h.shape
    f32 = jnp.float32
    z = h @ lp['w_in']
    splits = list(np.cumsum([D_A, D_A, DK_TOT, DK_TOT, DV_TOT, DV_TOT, 2 * GATE_RANK]))
    u_a, v_a, q, k, v, r, dec, gates = jnp.split(z, splits, axis=-1)

    heads = lambda a, d: a.astype(f32).reshape(B, T, GLA_HEADS, d)
    w_dec2 = lp['w_dec2'].astype(f32)
    b_dec = lp['b_dec'].astype(f32)
    dec_f, dec_b = jnp.split(dec.astype(f32), 2, axis=-1)
    lg_f = jax.nn.log_sigmoid(dec_f @ w_dec2[0] + b_dec[0]) / GATE_TAU
    lg_b = jax.nn.log_sigmoid(dec_b @ w_dec2[1] + b_dec[1]) / GATE_TAU
    o, s_f, s_b = bidir_gla(heads(q, DK) * DK ** -0.5, heads(k, DK), heads(v, DV),
                            heads(lg_f, DK), heads(lg_b, DK), s_f0, s_b0)
    if not with_output:
        return None, s_f, s_b

    on = o * lax.rsqrt(jnp.mean(o * o, -1, keepdims=True) + EPS) * lp['onorm_g'].astype(f32).reshape(GLA_HEADS, DV)
    y_b = on.reshape(B, T, DV_TOT).astype(h.dtype) * jax.nn.silu(r)

    y_a = chunk_mlp(jax.nn.gelu(u_a), jax.nn.gelu(v_a), lp['lnv_g'], lp['lnv_b'], lp['w_s'], lp['b_s'])

    g_a, g_b = jnp.split(jax.nn.sigmoid(gates), 2, axis=-1)
    merged = g_a * (y_a @ lp['proj_a']) + g_b * (y_b @ lp['proj_b'])
    return merged @ lp['w_out'], s_f, s_b


def sq_relu_mlp(h, w1, w2):
    return jnp.square(jax.nn.relu(h @ w1)) @ w2


def setup_inputs(seed: int = 0) -> dict:
    key = jax.random.key(seed)
    ks = jax.random.split(key, 24)
    nrm = lambda k, shape, s: jax.random.normal(k, shape, jnp.float32) * s
    return {
        "x": nrm(ks[0], (BATCH, SEQ, D_MODEL), 1.0),
        "c": nrm(ks[1], (BATCH, D_MODEL), 1.0),
        "ctx": nrm(ks[2], (BATCH, CTX_LEN, D_MODEL), 1.0),
        "c_ctx": nrm(ks[3], (D_MODEL,), 1.0),
        "w_ada": nrm(ks[4], (DEPTH, D_MODEL, 6 * D_MODEL), 0.5 * D_MODEL ** -0.5),
        "b_ada": nrm(ks[5], (DEPTH, 6 * D_MODEL), 0.02),
        "norm1_g": 1.0 + nrm(ks[6], (DEPTH, D_MODEL), 0.02),
        "w_in": nrm(ks[7], (DEPTH, D_MODEL, IN_COLS), D_MODEL ** -0.5),
        "lnv_g": 1.0 + nrm(ks[8], (DEPTH, D_A), 0.02),
        "lnv_b": nrm(ks[9], (DEPTH, D_A), 0.02),
        "w_s": nrm(ks[10], (DEPTH, A_GROUPS, CHUNK_A, CHUNK_A), CHUNK_A ** -0.5),
        "b_s": 1.0 + nrm(ks[11], (DEPTH, A_GROUPS, CHUNK_A), 0.02),
        "w_dec2": nrm(ks[12], (DEPTH, 2, GATE_RANK, DK_TOT), GATE_RANK ** -0.5),
        "b_dec": nrm(ks[13], (DEPTH, 2, DK_TOT), 0.1),
        "onorm_g": 1.0 + nrm(ks[14], (DEPTH, DV_TOT), 0.02),
        "proj_a": nrm(ks[15], (DEPTH, D_A, D_MODEL), D_A ** -0.5),
        "proj_b": nrm(ks[16], (DEPTH, DV_TOT, D_MODEL), DV_TOT ** -0.5),
        "w_out": nrm(ks[17], (DEPTH, D_MODEL, D_MODEL), D_MODEL ** -0.5),
        "norm2_g": 1.0 + nrm(ks[18], (DEPTH, D_MODEL), 0.02),
        "w_ff1": nrm(ks[19], (DEPTH, D_MODEL, D_FF), D_MODEL ** -0.5),
        "w_ff2": nrm(ks[20], (DEPTH, D_FF, D_MODEL), D_FF ** -0.5),
        "final_g": 1.0 + nrm(ks[21], (D_MODEL,), 0.02),
    }


def reference(x, c, ctx, c_ctx, w_ada, b_ada, norm1_g, w_in, lnv_g, lnv_b, w_s, b_s, w_dec2, b_dec,
              onorm_g, proj_a, proj_b, w_out, norm2_g, w_ff1, w_ff2, final_g):
    B, T, D = x.shape
    x = x + grid_pos_embed(T, D, x.dtype)[None]
    for i in range(DEPTH):
        last = i == DEPTH - 1
        lp = dict(w_in=w_in[i], lnv_g=lnv_g[i], lnv_b=lnv_b[i], w_s=w_s[i], b_s=b_s[i],
                  w_dec2=w_dec2[i], b_dec=b_dec[i], onorm_g=onorm_g[i],
                  proj_a=proj_a[i], proj_b=proj_b[i], w_out=w_out[i])
        mod_x = (jax.nn.silu(c) @ w_ada[i] + b_ada[i])[:, None, :]
        mod_c = (jax.nn.silu(c_ctx) @ w_ada[i] + b_ada[i])[None, None, :]
        sh1x, sc1x, g1x, sh2x, sc2x, g2x = jnp.split(mod_x, 6, axis=-1)
        sh1c, sc1c, g1c, sh2c, sc2c, g2c = jnp.split(mod_c, 6, axis=-1)

        zero = jnp.zeros((B, GLA_HEADS, DK, DV), jnp.float32)
        hc = modulate(ctx, norm1_g[i], sh1c, sc1c)
        yc, s_f, s_b = mixer(hc, zero, zero, lp, not last)
        hx = modulate(x, norm1_g[i], sh1x, sc1x)
        yx, _, _ = mixer(hx, s_f, s_b, lp, True)

        x = x + g1x * yx
        x = x + g2x * sq_relu_mlp(modulate(x, norm2_g[i], sh2x, sc2x), w_ff1[i], w_ff2[i])
        if not last:
            ctx = ctx + g1c * yc
            ctx = ctx + g2c * sq_relu_mlp(modulate(ctx, norm2_g[i], sh2c, sc2c), w_ff1[i], w_ff2[i])
    return rms_norm(x, final_g)
```

```cpp
#include <hip/hip_runtime.h>
#include <cstdio>
#include <cstdint>

#define LAS __attribute__((address_space(3)))
#define GAS __attribute__((address_space(1)))
typedef unsigned short bf16_t;
typedef short bf16x8 __attribute__((ext_vector_type(8)));
typedef short s16x4 __attribute__((ext_vector_type(4)));
typedef float f32x2 __attribute__((ext_vector_type(2)));
typedef float f32x4 __attribute__((ext_vector_type(4)));
typedef float f32x16 __attribute__((ext_vector_type(16)));
typedef unsigned u32x2 __attribute__((ext_vector_type(2)));
typedef unsigned u32x4 __attribute__((ext_vector_type(4)));
typedef __bf16 bf16x2_t __attribute__((ext_vector_type(2)));
#define DI __device__ __forceinline__

constexpr int DM = 1024, NB = 2, SEQ = 8192, M = NB * SEQ, CTXL = 256, MC = NB * CTXL, MT = M + MC, DFF = 4096;
constexpr int NZ = 7168;
constexpr int WIN_PITCH = 7200;
constexpr int NHEAD = 4, DK = 128, DV = 256, RANK = 16;
constexpr int NSC = 32;
constexpr float EPS = 1e-6f;

constexpr size_t MiB = 1u << 20;
constexpr size_t WS_CTL = 0, CTL_ZERO_BYTES = 1 * MiB;
constexpr size_t WS_POS = 1 * MiB;
constexpr size_t WS_MODP = 2 * MiB;
constexpr size_t WS_DEC = 3 * MiB;
constexpr size_t WS_MODF = 5 * MiB + 512 * 1024;
constexpr size_t WS_STAT = 6 * MiB;
constexpr size_t WS_WIN = 8 * MiB;
constexpr size_t WS_PA = 22 * MiB, WS_PB = 24 * MiB, WS_WO = 26 * MiB, WS_W1 = 28 * MiB, WS_W2 = 36 * MiB;
constexpr size_t WS_H = 44 * MiB;
constexpr size_t WS_GU = 77 * MiB, WS_GV = 109 * MiB, WS_Q = 141 * MiB, WS_K = 157 * MiB, WS_V = 173 * MiB, WS_R = 205 * MiB;
constexpr size_t WS_KC = 237 * MiB, WS_VC = 237 * MiB + 512 * 1024;
constexpr size_t WS_GAM = 239 * MiB;
constexpr size_t WS_END = 240 * MiB;
constexpr size_t WS_ST = WS_H;
constexpr size_t WS_OF = WS_GV;
constexpr size_t WS_MG = WS_Q;
constexpr size_t WS_T = WS_GU;
constexpr int CW_BAR = 4096;

constexpr int RING_BYTES = 131072, LDSCTL_OFF = RING_BYTES, MISC_OFF = LDSCTL_OFF + 320, LDS_BYTES = 147456;
constexpr int NWAVES = 8, NTHR = 512;

DI unsigned pk2(float lo, float hi) { f32x2 v = {lo, hi}; bf16x2_t b = __builtin_convertvector(v, bf16x2_t); return __builtin_bit_cast(unsigned, b); }
DI float bflo(unsigned w) { return __uint_as_float(w << 16); }
DI float bfhi(unsigned w) { return __uint_as_float(w & 0xffff0000u); }
DI float bf2f(bf16_t b) { return __uint_as_float(((unsigned)b) << 16); }
DI bf16_t f2bf(float f) { return (bf16_t)(pk2(f, 0.f) & 0xffffu); }
DI float sigm(float x) { return __builtin_amdgcn_rcpf(1.f + __builtin_amdgcn_exp2f(-1.4426950408889634f * x)); }
DI float wave_sum(float v) {
#pragma unroll
    for (int o = 1; o < 64; o <<= 1) v += __shfl_xor(v, o);
    return v;
}
DI int opaque(int x) { asm volatile("" : "+v"(x)); return x; }
#define LDS_WAIT() asm volatile("s_waitcnt lgkmcnt(0)" ::: "memory")
#define VM_WAIT() asm volatile("s_waitcnt vmcnt(0)" ::: "memory")

namespace pg8 {
constexpr int BM = 256, BK = 64, HALF = 128, HTB = HALF * BK * 2, STAGE_BYTES = 8 * HTB, NXCD = 8, WGM = 8;
__host__ __device__ __forceinline__ int lds_byte(int r, int c) { const int st = (r >> 4) * 2 + (c >> 5), rr = r & 15, cc = c & 31, ob = rr * 64 + cc * 2; return st * 1024 + (ob ^ (((ob >> 9) & 1) << 5)); }
__host__ __device__ __forceinline__ void stage_rc(int b, int& R, int& C) { const int st = b / 1024, sb = b % 1024, swz = sb ^ (((sb >> 9) & 1) << 5); R = (st >> 1) * 16 + swz / 64; C = (st & 1) * 32 + (swz % 64) / 2; }
__host__ __device__ __forceinline__ int perm32(int rho) { const int n = rho >> 4, i = rho & 15; return 8 * (i >> 2) + 4 * n + (i & 3); }

struct Unit { int pm, pn, sel; };
DI Unit unit_decode(int code) { Unit u; u.pm = code & 255; u.pn = (code >> 8) & 255; u.sel = (code >> 16) & 1; return u; }
struct Gemm { const bf16_t* A0; const bf16_t* A1; const bf16_t* B0; const bf16_t* B1; int lda, ldb, K; };

DI void tile_order(int L, int nM, int nN, int& pm, int& pn) {
    const int nwg = nM * nN; int wgid = L;
    { const int q = nwg / NXCD, r = nwg % NXCD, xcd = wgid % NXCD, off = wgid / NXCD; wgid = (xcd < r ? xcd * (q + 1) : r * (q + 1) + (xcd - r) * q) + off; }
    const int nig = WGM * nN, gid = wgid / nig, fm = gid * WGM, gsz = (nM - fm) < WGM ? (nM - fm) : WGM;
    pm = fm + ((wgid % nig) % gsz); pn = (wgid % nig) / gsz;
}
struct StaticOrder {
    int nM, nN, nwg, G, c;
    DI void init(int M_, int N_, int G_, int c_) { nM = M_ / BM; nN = N_ / BM; nwg = nM * nN; G = G_; c = c_; }
    DI int next(int i) const { const long L = (long)i * G + c; if (L >= nwg) return -1; int pm, pn; tile_order((int)L, nM, nN, pm, pn); return pm | (pn << 8); }
};

template <class Epi, class Sched, bool ALIGN_EPI>
DI void gemm_phase(LAS unsigned char* lds, const Gemm g, const Sched& S, const Epi& E) {
    const int tid = threadIdx.x, wid = __builtin_amdgcn_readfirstlane(tid >> 6), lane = tid & 63, wr = wid >> 2, wc = wid & 3, fr = lane & 15, fq = lane >> 4;
    const int nt = g.K / BK;
    unsigned voffA[2], voffB[2]; int aoff, boff;
#define PG8_LANE_CONSTS() do { const int t_ = opaque(tid); const int l_ = t_ & 63; \
        _Pragma("unroll") for (int i = 0; i < 2; ++i) { int R, C; stage_rc(t_ * 16 + i * 8192, R, C); const int Rb = Epi::PERM ? ((R & ~31) + perm32(R & 31)) : R; \
            voffA[i] = (unsigned)(R * g.lda + C) * 2u; voffB[i] = (unsigned)(Rb * g.ldb + C) * 2u; } \
        aoff = lds_byte(wr * 64 + (l_ & 15), (l_ >> 4) * 8); boff = lds_byte(wc * 32 + (l_ & 15), (l_ >> 4) * 8); } while (0)
    PG8_LANE_CONSTS();
    const size_t kstep = (size_t)(BK * 2);
    const size_t hstepA = (size_t)HALF * g.lda * 2, hstepB = (size_t)HALF * g.ldb * 2;
    const size_t tstepA = 2 * hstepA, tstepB = 2 * hstepB;
    const unsigned ldsw = (unsigned)wid * 1024u;
#define PG8_SA(b, h) (((b) * 2 + (h)) * HTB)
#define PG8_SB(b, h) ((4 + (b) * 2 + (h)) * HTB)
#define PG8_STAGE(bufoff, gbase, voff) do { _Pragma("unroll") for (int _i = 0; _i < 2; ++_i) \
        __builtin_amdgcn_global_load_lds((const unsigned*)((const char*)(gbase) + (voff)[_i]), (LAS unsigned*)(lds + (bufoff) + ldsw + _i * 8192), 16, 0, 0); } while (0)
#define PG8_LDA(dst, b, h) do { _Pragma("unroll") for (int m = 0; m < 4; ++m) _Pragma("unroll") for (int k = 0; k < 2; ++k) dst[m][k] = *(const LAS bf16x8*)(lds + PG8_SA(b, h) + aoff + m * 2048 + k * 1024); } while (0)
#define PG8_LDB(dst, b, h) do { _Pragma("unroll") for (int n = 0; n < 2; ++n) _Pragma("unroll") for (int k = 0; k < 2; ++k) dst[n][k] = *(const LAS bf16x8*)(lds + PG8_SB(b, h) + boff + n * 2048 + k * 1024); } while (0)
#define PG8_MMA(ai, bj, At, Bt) do { __builtin_amdgcn_s_setprio(1); _Pragma("unroll") for (int m = 0; m < 4; ++m) _Pragma("unroll") for (int n = 0; n < 2; ++n) _Pragma("unroll") for (int k = 0; k < 2; ++k) \
        acc[ai][bj][m][n] = __builtin_amdgcn_mfma_f32_16x16x32_bf16(Bt[n][k], At[m][k], acc[ai][bj][m][n], 0, 0, 0); __builtin_amdgcn_s_setprio(0); } while (0)
#define PG8_WAIT_V(n) asm volatile("s_waitcnt vmcnt(" #n ")" ::: "memory")
#define PG8_WAIT_L(n) asm volatile("s_waitcnt lgkmcnt(" #n ")" ::: "memory")
#define PG8_BAR __builtin_amdgcn_s_barrier()
#define PG8_SCHED __builtin_amdgcn_sched_barrier(0)
    int ui = 0;
    const int cu0 = S.next(0);
    if (cu0 < 0) return;
    Unit cur = unit_decode(cu0), nxt = cur;
    f32x4 acc[2][2][4][2];
#pragma unroll
    for (int a = 0; a < 2; ++a)
#pragma unroll
        for (int b = 0; b < 2; ++b)
#pragma unroll
            for (int m = 0; m < 4; ++m)
#pragma unroll
                for (int n = 0; n < 2; ++n) acc[a][b][m][n] = (f32x4){0.f, 0.f, 0.f, 0.f};
    bf16x8 At[4][2], B0[2][2], B1[2][2];
    const char* cA = (const char*)(cur.sel ? g.A1 : g.A0) + (size_t)cur.pm * tstepA; const char* cB = (const char*)(cur.sel ? g.B1 : g.B0) + (size_t)cur.pn * tstepB;
    PG8_STAGE(PG8_SB(0, 0), cB, voffB); PG8_STAGE(PG8_SB(0, 1), cB + hstepB, voffB); PG8_STAGE(PG8_SA(0, 0), cA, voffA); PG8_STAGE(PG8_SA(0, 1), cA + hstepA, voffA);
    if (wr == 1) PG8_BAR;
    PG8_WAIT_V(2); PG8_BAR;
    PG8_STAGE(PG8_SB(1, 0), cB + kstep, voffB); PG8_STAGE(PG8_SA(1, 0), cA + kstep, voffA); PG8_STAGE(PG8_SB(1, 1), cB + hstepB + kstep, voffB);
    PG8_WAIT_V(6); PG8_BAR;
    for (;;) {
        if (ui > 0) PG8_LANE_CONSTS();
        const int cun = S.next(ui + 1); const bool has_next = cun >= 0;
        if (has_next) nxt = unit_decode(cun);
        const char* nA = has_next ? (const char*)(nxt.sel ? g.A1 : g.A0) + (size_t)nxt.pm * tstepA : cA; const char* nB = has_next ? (const char*)(nxt.sel ? g.B1 : g.B0) + (size_t)nxt.pn * tstepB : cB;
        for (int t = 0; t < nt; t += 2) {
            const bool last = (t == nt - 2);
            const char* a1 = cA + (size_t)(t + 1) * kstep;
            const char* a2 = last ? nA : cA + (size_t)(t + 2) * kstep; const char* b2 = last ? nB : cB + (size_t)(t + 2) * kstep;
            const char* a3 = a2 + kstep; const char* b3 = b2 + kstep;
            PG8_LDB(B0, 0, 0); PG8_LDB(B1, 0, 1); PG8_SCHED; PG8_LDA(At, 0, 0); PG8_STAGE(PG8_SA(1, 1), a1 + hstepA, voffA);
            PG8_WAIT_V(8); PG8_WAIT_L(0); PG8_BAR; PG8_MMA(0, 0, At, B0); PG8_MMA(0, 1, At, B1); PG8_BAR; PG8_SCHED;
            PG8_LDA(At, 0, 1); PG8_STAGE(PG8_SB(0, 0), b2, voffB); PG8_STAGE(PG8_SB(0, 1), b2 + hstepB, voffB); PG8_STAGE(PG8_SA(0, 0), a2, voffA);
            PG8_WAIT_V(8); PG8_WAIT_L(0); PG8_BAR; PG8_MMA(1, 0, At, B0); PG8_MMA(1, 1, At, B1); PG8_BAR; PG8_SCHED;
            PG8_LDB(B0, 1, 0); PG8_LDB(B1, 1, 1); PG8_SCHED; PG8_LDA(At, 1, 0); PG8_STAGE(PG8_SA(0, 1), a2 + hstepA, voffA);
            PG8_WAIT_V(8); PG8_WAIT_L(0); PG8_BAR; PG8_MMA(0, 0, At, B0); PG8_MMA(0, 1, At, B1); PG8_BAR; PG8_SCHED;
            PG8_LDA(At, 1, 1); PG8_STAGE(PG8_SB(1, 0), b3, voffB); PG8_STAGE(PG8_SB(1, 1), b3 + hstepB, voffB); PG8_STAGE(PG8_SA(1, 0), a3, voffA);
            PG8_WAIT_V(8); PG8_WAIT_L(0); PG8_BAR; PG8_MMA(1, 0, At, B0); PG8_MMA(1, 1, At, B1); PG8_BAR; PG8_SCHED;
        }
        if constexpr (ALIGN_EPI) { if (wr == 0) PG8_BAR; }
        { const int le_ = opaque(tid) & 63; E(acc, cur, wr, wc, le_ & 15, le_ >> 4); }
        if (!has_next) break;
#pragma unroll
        for (int a = 0; a < 2; ++a)
#pragma unroll
            for (int b = 0; b < 2; ++b)
#pragma unroll
                for (int m = 0; m < 4; ++m)
#pragma unroll
                    for (int n = 0; n < 2; ++n) acc[a][b][m][n] = (f32x4){0.f, 0.f, 0.f, 0.f};
        cur = nxt; cA = nA; cB = nB; ++ui;
        if constexpr (ALIGN_EPI) { if (wr == 1) PG8_BAR; }
    }
    PG8_WAIT_V(0);
    if constexpr (!ALIGN_EPI) { if (wr == 0) PG8_BAR; }
    PG8_BAR;
#undef PG8_LANE_CONSTS
#undef PG8_SA
#undef PG8_SB
#undef PG8_STAGE
#undef PG8_LDA
#undef PG8_LDB
#undef PG8_MMA
#undef PG8_WAIT_V
#undef PG8_WAIT_L
#undef PG8_BAR
#undef PG8_SCHED
}
}

#define XB_TMO      128
#define XB_XCNT(j)  (256  + 64 * (j))
#define XB_XSUB(j)  (1280 + 64 * (j))
#define XB_XGEN(j)  (2304 + 64 * (j))
#define XB_TOP      3328
#define XB_TOPGEN   3392
#define XCD_BAR_WORDS 3456
#define XB_SPIN_CAP (1u << 20)
DI unsigned xb_ld(unsigned* p)              { return __hip_atomic_load(p, __ATOMIC_RELAXED, __HIP_MEMORY_SCOPE_AGENT); }
DI unsigned xb_add(unsigned* p, unsigned v) { return __hip_atomic_fetch_add(p, v, __ATOMIC_RELAXED, __HIP_MEMORY_SCOPE_AGENT); }
DI unsigned xb_xcc_id() { return (unsigned)__builtin_amdgcn_s_getreg((3 << 11) | 20) & 0xFu; }
#define XB_SPIN(cond, bar) do { unsigned _sp = 0; while (cond) { __builtin_amdgcn_s_sleep(1); \
    if ((++_sp & 255u) == 0u) { if (xb_ld(&(bar)[XB_TMO])) break; if (_sp > XB_SPIN_CAP) { atomicAdd(&(bar)[XB_TMO], 1u); break; } } } } while (0)
struct XcdBarrier { unsigned* bar; unsigned x; volatile LAS unsigned* st; };
DI XcdBarrier xcd_barrier_post(unsigned* bar, volatile LAS unsigned* st) {
    XcdBarrier b; b.bar = bar; b.x = xb_xcc_id(); b.st = st;
    if (threadIdx.x == 0) (void)xb_add(&bar[XB_XCNT(b.x)], 1u);
    return b;
}
DI void xcd_barrier_complete(unsigned* bar, unsigned x, unsigned& nloc, unsigned& nx) {
    const unsigned G = gridDim.x * gridDim.y * gridDim.z;
    unsigned sum, cnt, mine, sp = 0u;
    for (;;) {
        sum = 0u; cnt = 0u; mine = 0u;
#pragma unroll
        for (unsigned j = 0; j < 16; ++j) { const unsigned c = xb_ld(&bar[XB_XCNT(j)]); sum += c; cnt += (c > 0u) ? 1u : 0u; mine = (j == x) ? c : mine; }
        if (sum == G) break;
        __builtin_amdgcn_s_sleep(1);
        if ((++sp & 255u) == 0u) { if (xb_ld(&bar[XB_TMO])) break; if (sp > XB_SPIN_CAP) { atomicAdd(&bar[XB_TMO], 1u); break; } }
    }
    nloc = mine > 0u ? mine : 1u; nx = cnt > 0u ? cnt : 1u;
}
DI void xcd_barrier(const XcdBarrier& b) {
    asm volatile("s_waitcnt vmcnt(0)" ::: "memory");
    __syncthreads();
    if (threadIdx.x == 0) {
        unsigned* bar = b.bar;
        __builtin_amdgcn_s_waitcnt(0);
        unsigned nloc = b.st[0], nx = b.st[1];
        if (nloc == 0u) { xcd_barrier_complete(bar, b.x, nloc, nx); b.st[0] = nloc; b.st[1] = nx; }
        const unsigned old = xb_add(&bar[XB_XSUB(b.x)], 1u);
        const unsigned gen = old / nloc;
        if (old + 1u == (gen + 1u) * nloc) {
            __builtin_amdgcn_fence(__ATOMIC_RELEASE, "agent");
            asm volatile("s_waitcnt vmcnt(0)" ::: "memory");
            const unsigned og = xb_add(&bar[XB_TOP], 1u);
            const unsigned tg = og / nx;
            if (og + 1u == (tg + 1u) * nx) xb_add(&bar[XB_TOPGEN], 1u);
            else XB_SPIN(xb_ld(&bar[XB_TOPGEN]) == tg, bar);
            __builtin_amdgcn_fence(__ATOMIC_ACQUIRE, "agent");
            xb_add(&bar[XB_XGEN(b.x)], 1u);
            asm volatile("s_waitcnt vmcnt(0)" ::: "memory");
        } else {
            XB_SPIN(xb_ld(&bar[XB_XGEN(b.x)]) == gen, bar);
            __builtin_amdgcn_fence(__ATOMIC_ACQUIRE, "agent");
            asm volatile("s_waitcnt vmcnt(0)" ::: "memory");
        }
    }
    __syncthreads();
}

struct Args { const float* in[22]; float* out; unsigned char* ws; };
enum { I_X = 0, I_C, I_CTX, I_CCTX, I_WADA, I_BADA, I_N1G, I_WIN, I_LNVG, I_LNVB, I_WS, I_BS, I_WDEC2, I_BDEC, I_ONG, I_PA, I_PB, I_WOUT, I_N2G, I_WFF1, I_WFF2, I_FING };

DI void p0_transpose_item(const float* W, int pitch, int K, int nblk, bf16_t* WT, int row_off, LAS float* scr, int item, int lane) {
    const int kb = item / nblk, nb = item % nblk, k0 = 64 * kb, n0 = 32 * nb;
#pragma unroll 8
    for (int i = 0; i < 32; ++i) { const int kk = 2 * i + (lane >> 5); scr[kk * 33 + (lane & 31)] = W[(size_t)(k0 + kk) * pitch + n0 + (lane & 31)]; }
    LDS_WAIT(); asm volatile("" ::: "memory");
    const int c = lane & 7;
#pragma unroll
    for (int j = 0; j < 4; ++j) { const int n = (lane >> 3) + 8 * j; const LAS float* s = scr + (8 * c) * 33 + n;
        u32x4 o; o.x = pk2(s[0 * 33], s[1 * 33]); o.y = pk2(s[2 * 33], s[3 * 33]); o.z = pk2(s[4 * 33], s[5 * 33]); o.w = pk2(s[6 * 33], s[7 * 33]);
        *(u32x4*)(WT + (size_t)(row_off + n0 + n) * K + k0 + 8 * c) = o; }
    LDS_WAIT(); asm volatile("" ::: "memory");
}
DI void p0_prologue(const Args& a, LAS unsigned char* lds, int vcu, int G, int wave, int lane) {
    unsigned char* ws = a.ws;
    LAS float* scr = (LAS float*)(lds + wave * 16384);
    const int gw = vcu * NWAVES + wave, NGW = G * NWAVES;
    constexpr int I_IN1 = 16 * 160, I_IN2 = 16 * 64, I_SQ = 16 * 32, I_F1 = 16 * 128, I_F2 = 64 * 32;
    constexpr int NITEMS = I_IN1 + I_IN2 + 3 * I_SQ + I_F1 + I_F2;
    for (int it = gw; it < NITEMS; it += NGW) {
        int r = it;
        if (r < I_IN1) { p0_transpose_item(a.in[I_WIN], WIN_PITCH, DM, 160, (bf16_t*)(ws + WS_WIN), 0, scr, r, lane); continue; } r -= I_IN1;
        if (r < I_IN2) { p0_transpose_item(a.in[I_WIN] + 5152, WIN_PITCH, DM, 64, (bf16_t*)(ws + WS_WIN), 5120, scr, r, lane); continue; } r -= I_IN2;
        if (r < I_SQ) { p0_transpose_item(a.in[I_PA], DM, DM, 32, (bf16_t*)(ws + WS_PA), 0, scr, r, lane); continue; } r -= I_SQ;
        if (r < I_SQ) { p0_transpose_item(a.in[I_PB], DM, DM, 32, (bf16_t*)(ws + WS_PB), 0, scr, r, lane); continue; } r -= I_SQ;
        if (r < I_SQ) { p0_transpose_item(a.in[I_WOUT], DM, DM, 32, (bf16_t*)(ws + WS_WO), 0, scr, r, lane); continue; } r -= I_SQ;
        if (r < I_F1) { p0_transpose_item(a.in[I_WFF1], DFF, DM, 128, (bf16_t*)(ws + WS_W1), 0, scr, r, lane); continue; } r -= I_F1;
        p0_transpose_item(a.in[I_WFF2], DM, DFF, 32, (bf16_t*)(ws + WS_W2), 0, scr, r, lane);
    }
    {
        const float* wada = a.in[I_WADA]; const float* cc = a.in[I_C]; const float* cx = a.in[I_CCTX];
        float* modp = (float*)(ws + WS_MODP);
        for (int it = (NGW - 1 - gw); it < 8 * 96; it += NGW) {
            const int ks = it / 96, cb = it % 96, col = cb * 64 + lane;
            float a0 = 0.f, a1 = 0.f, a2 = 0.f;
#pragma unroll 4
            for (int k = 0; k < 128; ++k) {
                const int kk = ks * 128 + k;
                const float w = wada[(size_t)kk * 6144 + col];
                const float c0 = cc[kk], c1 = cc[DM + kk], c2 = cx[kk];
                a0 += c0 * sigm(c0) * w; a1 += c1 * sigm(c1) * w; a2 += c2 * sigm(c2) * w;
            }
            modp[(ks * 3 + 0) * 6144 + col] = a0; modp[(ks * 3 + 1) * 6144 + col] = a1; modp[(ks * 3 + 2) * 6144 + col] = a2;
        }
    }
    {
        float* pos = (float*)(ws + WS_POS);
        const int gt = gw * 64 + lane, NT = NGW * 64;
        for (int e = gt; e < 192 * 512; e += NT) {
            const int p = e >> 9, ch = e & 511;
            const int prow = p < 128 ? p : p - 128;
            const int fi = ch & 255;
            const float pw = (float)pow(10000.0, (double)((float)fi * (1.0f / 256.0f)));
            const float fr = 1.0f / pw;
            const float ang = (float)prow * fr;
            const double dv = (ch < 256) ? sin((double)ang) : cos((double)ang);
            pos[e] = (float)dv;
        }
    }
}

DI void p1_rows(const Args& a, LAS unsigned char* lds, int vcu, int G, int wave, int lane, int tid) {
    unsigned char* ws = a.ws;
    const float* modp = (const float*)(ws + WS_MODP); const float* bada = a.in[I_BADA];
    LAS float* modl = (LAS float*)lds;
    for (int idx = tid; idx < 3 * 2048; idx += NTHR) {
        const int v = idx >> 11, col = idx & 2047;
        float s = bada[col];
#pragma unroll
        for (int ks = 0; ks < 8; ++ks) s += modp[(ks * 3 + v) * 6144 + col];
        modl[idx] = s;
    }
    if (blockIdx.x < 36) {
        const int idx = blockIdx.x * NTHR + tid; const int v = idx / 6144, col = idx % 6144;
        float s = bada[col];
#pragma unroll
        for (int ks = 0; ks < 8; ++ks) s += modp[(ks * 3 + v) * 6144 + col];
        ((float*)(ws + WS_MODF))[idx] = s;
    }
    __syncthreads();
    const float* pos = (const float*)(ws + WS_POS);
    const float* g1 = a.in[I_N1G];
    bf16_t* H = (bf16_t*)(ws + WS_H);
    const int gw = vcu * NWAVES + wave, NGW = G * NWAVES;
    for (int m = gw; m < MT; m += NGW) {
        const float* xr; int v; const float* pr = nullptr; const float* pc = nullptr;
        if (m < M) { xr = a.in[I_X] + (size_t)m * DM; v = m >> 13; const int t = m & (SEQ - 1); pr = pos + (size_t)(t >> 6) * 512; pc = pos + (size_t)(128 + (t & 63)) * 512; }
        else { xr = a.in[I_CTX] + (size_t)(m - M) * DM; v = 2; }
        f32x4 x[4]; float ss = 0.f;
#pragma unroll
        for (int j = 0; j < 4; ++j) {
            x[j] = *(const f32x4*)(xr + 256 * j + 4 * lane);
            if (m < M) { const float* pp = (j < 2 ? pr + 256 * j : pc + 256 * (j - 2)) + 4 * lane; x[j] += *(const f32x4*)pp; }
            ss += (x[j].x * x[j].x + x[j].y * x[j].y) + (x[j].z * x[j].z + x[j].w * x[j].w);
        }
        const float rs = rsqrtf(wave_sum(ss) * (1.f / DM) + EPS);
        unsigned long long* o8 = (unsigned long long*)(H + (size_t)m * DM) + lane;
#pragma unroll
        for (int j = 0; j < 4; ++j) {
            const int ch = 256 * j + 4 * lane;
            const f32x4 g = *(const f32x4*)(g1 + ch);
            const f32x4 sh = *(const LAS f32x4*)(modl + v * 2048 + ch), sc = *(const LAS f32x4*)(modl + v * 2048 + 1024 + ch);
            const f32x4 h = x[j] * rs * g * (sc + 1.f) + sh;
            o8[64 * j] = (unsigned long long)pk2(h.x, h.y) | ((unsigned long long)pk2(h.z, h.w) << 32);
        }
    }
}
DI void p5c_rows(const Args& a, int vcu, int G, int wave, int lane) {
    unsigned char* ws = a.ws;
    const float* modf = (const float*)(ws + WS_MODF); const float* g2 = a.in[I_N2G];
    bf16_t* H = (bf16_t*)(ws + WS_H);
    const int gw = vcu * NWAVES + wave, NGW = G * NWAVES;
    for (int m = gw; m < M; m += NGW) {
        const float* xr = a.out + (size_t)m * DM; const int v = m >> 13;
        f32x4 x[4]; float ss = 0.f;
#pragma unroll
        for (int j = 0; j < 4; ++j) { x[j] = *(const f32x4*)(xr + 256 * j + 4 * lane); ss += (x[j].x * x[j].x + x[j].y * x[j].y) + (x[j].z * x[j].z + x[j].w * x[j].w); }
        const float rs = rsqrtf(wave_sum(ss) * (1.f / DM) + EPS);
        unsigned long long* o8 = (unsigned long long*)(H + (size_t)m * DM) + lane;
#pragma unroll
        for (int j = 0; j < 4; ++j) {
            const int ch = 256 * j + 4 * lane;
            const f32x4 g = *(const f32x4*)(g2 + ch);
            const f32x4 sh = *(const f32x4*)(modf + v * 6144 + 3 * 1024 + ch), sc = *(const f32x4*)(modf + v * 6144 + 4 * 1024 + ch);
            const f32x4 h = x[j] * rs * g * (sc + 1.f) + sh;
            o8[64 * j] = (unsigned long long)pk2(h.x, h.y) | ((unsigned long long)pk2(h.z, h.w) << 32);
        }
    }
}
DI void p7_rows(const Args& a, int vcu, int G, int wave, int lane) {
    const float* fg = a.in[I_FING];
    const int gw = vcu * NWAVES + wave, NGW = G * NWAVES;
    for (int m = gw; m < M; m += NGW) {
        float* xr = a.out + (size_t)m * DM;
        f32x4 x[4]; float ss = 0.f;
#pragma unroll
        for (int j = 0; j < 4; ++j) { x[j] = *(const f32x4*)(xr + 256 * j + 4 * lane); ss += (x[j].x * x[j].x + x[j].y * x[j].y) + (x[j].z * x[j].z + x[j].w * x[j].w); }
        const float rs = rsqrtf(wave_sum(ss) * (1.f / DM) + EPS);
#pragma unroll
        for (int j = 0; j < 4; ++j) { const int ch = 256 * j + 4 * lane; const f32x4 g = *(const f32x4*)(fg + ch); *(f32x4*)(xr + ch) = x[j] * rs * g; }
    }
}

template <int ACT> DI float actf(float x, float scale) {
    if (ACT == 0) return x * scale;
    if (ACT == 1) return x * sigm(x * (1.5957691216057308f + 0.07135481627362205f * x * x));
    if (ACT == 2) return x * sigm(x);
    if (ACT == 3) return sigm(x);
    return x;
}
struct EpiZ {
    static constexpr bool PERM = true;
    unsigned char* ws; bf16_t* gates;
    template <int ACT, bool STATS> DI void run(const f32x4 (&acc)[2][2][4][2], bf16_t* base, int ldc, int row0, int col0, float scale, float* stat, int slot, int fq) const {
#pragma unroll
        for (int ai = 0; ai < 2; ++ai)
#pragma unroll
            for (int m = 0; m < 4; ++m) {
                const int row = row0 + ai * 128 + m * 16; bf16_t* rowp = base + (size_t)row * ldc + col0;
                float s = 0.f, q = 0.f;
#pragma unroll
                for (int bj = 0; bj < 2; ++bj) {
                    float v[8];
#pragma unroll
                    for (int e = 0; e < 4; ++e) { v[e] = actf<ACT>(acc[ai][bj][m][0][e], scale); v[4 + e] = actf<ACT>(acc[ai][bj][m][1][e], scale); }
                    if (STATS) {
#pragma unroll
                        for (int e = 0; e < 8; ++e) { s += v[e]; q += v[e] * v[e]; } }
                    u32x4 w; w.x = pk2(v[0], v[1]); w.y = pk2(v[2], v[3]); w.z = pk2(v[4], v[5]); w.w = pk2(v[6], v[7]);
                    *(u32x4*)(rowp + bj * 128) = w;
                    __builtin_amdgcn_sched_barrier(0);
                }
                if (STATS) {
                    s += __shfl_xor(s, 16); s += __shfl_xor(s, 32); q += __shfl_xor(q, 16); q += __shfl_xor(q, 32);
                    if (fq == 0) *(f32x2*)(stat + ((size_t)row * 16 + slot) * 2) = (f32x2){s, q};
                }
                __builtin_amdgcn_sched_barrier(0);
            }
    }
    DI void operator()(const f32x4 (&acc)[2][2][4][2], const pg8::Unit& u, int wr, int wc, int fr, int fq) const {
        const int pn = u.pn, row0 = u.pm * 256 + wr * 64 + fr, cw = wc * 32 + 8 * fq;
        if (u.sel == 1) {
            if (pn < 12) run<0, false>(acc, (bf16_t*)(ws + WS_KC), 512, row0, (pn - 10) * 256 + cw, 1.f, nullptr, 0, fq);
            else run<0, false>(acc, (bf16_t*)(ws + WS_VC), 1024, row0, (pn - 12) * 256 + cw, 1.f, nullptr, 0, fq);
            return;
        }
        if (pn < 4) run<1, false>(acc, (bf16_t*)(ws + WS_GU), 1024, row0, pn * 256 + cw, 1.f, nullptr, 0, fq);
        else if (pn < 8) run<1, true>(acc, (bf16_t*)(ws + WS_GV), 1024, row0, (pn - 4) * 256 + cw, 1.f, (float*)(ws + WS_STAT), (pn - 4) * 4 + wc, fq);
        else if (pn < 10) run<0, false>(acc, (bf16_t*)(ws + WS_Q), 512, row0, (pn - 8) * 256 + cw, 0.08838834764831845f, nullptr, 0, fq);
        else if (pn < 12) run<0, false>(acc, (bf16_t*)(ws + WS_K), 512, row0, (pn - 10) * 256 + cw, 1.f, nullptr, 0, fq);
        else if (pn < 16) run<0, false>(acc, (bf16_t*)(ws + WS_V), 1024, row0, (pn - 12) * 256 + cw, 1.f, nullptr, 0, fq);
        else if (pn < 20) run<2, false>(acc, (bf16_t*)(ws + WS_R), 1024, row0, (pn - 16) * 256 + cw, 1.f, nullptr, 0, fq);
        else run<3, false>(acc, gates, 2048, row0, (pn - 20) * 256 + cw, 1.f, nullptr, 0, fq);
    }
};
struct SchedP2 {
    int G, c;
    DI int next(int i) const {
        int L = i * G + c;
        if (L < 64 * 28) { int pm, pn; pg8::tile_order(L, 64, 28, pm, pn); return pm | (pn << 8); }
        L -= 64 * 28;
        if (L < 12) return (L / 6) | ((10 + (L % 6)) << 8) | (1 << 16);
        return -1;
    }
};
struct EpiMerge {
    static constexpr bool PERM = true;
    bf16_t* MG; const bf16_t* gates;
    DI void operator()(const f32x4 (&acc)[2][2][4][2], const pg8::Unit& u, int wr, int wc, int fr, int fq) const {
        const int row0 = u.pm * 256 + wr * 64 + fr, col0 = u.pn * 256 + wc * 32 + 8 * fq;
#pragma unroll
        for (int ai = 0; ai < 2; ++ai)
#pragma unroll
            for (int m = 0; m < 4; ++m) {
                const int row = row0 + ai * 128 + m * 16;
#pragma unroll
                for (int bj = 0; bj < 2; ++bj) {
                    const int col = col0 + bj * 128;
                    const u32x4 gw = *(const u32x4*)(gates + (size_t)row * 2048 + u.sel * 1024 + col);
                    bf16_t* mp = MG + (size_t)row * DM + col;
                    float v[8];
                    v[0] = bflo(gw.x) * acc[ai][bj][m][0][0]; v[1] = bfhi(gw.x) * acc[ai][bj][m][0][1]; v[2] = bflo(gw.y) * acc[ai][bj][m][0][2]; v[3] = bfhi(gw.y) * acc[ai][bj][m][0][3];
                    v[4] = bflo(gw.z) * acc[ai][bj][m][1][0]; v[5] = bfhi(gw.z) * acc[ai][bj][m][1][1]; v[6] = bflo(gw.w) * acc[ai][bj][m][1][2]; v[7] = bfhi(gw.w) * acc[ai][bj][m][1][3];
                    if (u.sel == 1) {
                        const u32x4 pv = *(const u32x4*)mp;
                        v[0] += bflo(pv.x); v[1] += bfhi(pv.x); v[2] += bflo(pv.y); v[3] += bfhi(pv.y); v[4] += bflo(pv.z); v[5] += bfhi(pv.z); v[6] += bflo(pv.w); v[7] += bfhi(pv.w);
                    }
                    u32x4 w; w.x = pk2(v[0], v[1]); w.y = pk2(v[2], v[3]); w.z = pk2(v[4], v[5]); w.w = pk2(v[6], v[7]);
                    *(u32x4*)mp = w;
                }
            }
    }
};
struct SchedMerge {
    int G, c;
    DI int next(int i) const {
        const int tile = (i >> 1) * G + c; if (tile >= 256) return -1;
        int pm, pn; pg8::tile_order(tile, 64, 4, pm, pn); return pm | (pn << 8) | ((i & 1) << 16);
    }
};
struct EpiRes1 {
    static constexpr bool PERM = false;
    const float* x; const float* pos; const float* modf; float* out;
    DI void operator()(const f32x4 (&acc)[2][2][4][2], const pg8::Unit& u, int wr, int wc, int fr, int fq) const {
        const int row0 = u.pm * 256 + wr * 64 + fr, col0 = u.pn * 256 + wc * 32 + 4 * fq;
        const float* g1 = modf + (u.pm >> 5) * 6144 + 2 * 1024;
#pragma unroll
        for (int ai = 0; ai < 2; ++ai)
#pragma unroll
            for (int m = 0; m < 4; ++m) {
                const int row = row0 + ai * 128 + m * 16, t = row & (SEQ - 1);
#pragma unroll
                for (int bj = 0; bj < 2; ++bj)
#pragma unroll
                    for (int n = 0; n < 2; ++n) {
                        const int col = col0 + bj * 128 + n * 16;
                        const float* pp = (col < 512) ? pos + (size_t)(t >> 6) * 512 + col : pos + (size_t)(128 + (t & 63)) * 512 + (col - 512);
                        const f32x4 xv = *(const f32x4*)(x + (size_t)row * DM + col), pv = *(const f32x4*)pp, gv = *(const f32x4*)(g1 + col);
                        *(f32x4*)(out + (size_t)row * DM + col) = xv + pv + gv * acc[ai][bj][m][n];
                    }
            }
    }
};
struct EpiFF1 {
    static constexpr bool PERM = true;
    bf16_t* T;
    DI void operator()(const f32x4 (&acc)[2][2][4][2], const pg8::Unit& u, int wr, int wc, int fr, int fq) const {
        const int row0 = u.pm * 256 + wr * 64 + fr, col0 = u.pn * 256 + wc * 32 + 8 * fq;
#pragma unroll
        for (int ai = 0; ai < 2; ++ai)
#pragma unroll
            for (int m = 0; m < 4; ++m) {
                bf16_t* rowp = T + (size_t)(row0 + ai * 128 + m * 16) * DFF + col0;
#pragma unroll
                for (int bj = 0; bj < 2; ++bj) {
                    float v[8];
#pragma unroll
                    for (int e = 0; e < 4; ++e) { const float a0 = fmaxf(acc[ai][bj][m][0][e], 0.f), a1 = fmaxf(acc[ai][bj][m][1][e], 0.f); v[e] = a0 * a0; v[4 + e] = a1 * a1; }
                    u32x4 w; w.x = pk2(v[0], v[1]); w.y = pk2(v[2], v[3]); w.z = pk2(v[4], v[5]); w.w = pk2(v[6], v[7]);
                    *(u32x4*)(rowp + bj * 128) = w;
                }
            }
    }
};
struct EpiRes2 {
    static constexpr bool PERM = false;
    const float* modf; float* out;
    DI void operator()(const f32x4 (&acc)[2][2][4][2], const pg8::Unit& u, int wr, int wc, int fr, int fq) const {
        const int row0 = u.pm * 256 + wr * 64 + fr, col0 = u.pn * 256 + wc * 32 + 4 * fq;
        const float* g2 = modf + (u.pm >> 5) * 6144 + 5 * 1024;
#pragma unroll
        for (int ai = 0; ai < 2; ++ai)
#pragma unroll
            for (int m = 0; m < 4; ++m) {
                const int row = row0 + ai * 128 + m * 16;
#pragma unroll
                for (int bj = 0; bj < 2; ++bj)
#pragma unroll
                    for (int n = 0; n < 2; ++n) {
                        const int col = col0 + bj * 128 + n * 16;
                        float* op = out + (size_t)row * DM + col;
                        const f32x4 xv = *(const f32x4*)op, gv = *(const f32x4*)(g2 + col);
                        *(f32x4*)op = xv + gv * acc[ai][bj][m][n];
                    }
            }
    }
};

DI int crow(int reg, int h) { return (reg & 3) + 8 * (reg >> 2) + 4 * h; }
DI void mma32(f32x16& acc, const LAS unsigned char* A, int pitchA, const LAS unsigned char* B, int pitchB, int K, int lane) {
    const int r = lane & 31, h = lane >> 5;
    const LAS unsigned char* pa = A + r * pitchA + h * 16;
    const LAS unsigned char* pb = B + r * pitchB + h * 16;
#pragma unroll 4
    for (int k = 0; k < K; k += 16) {
        const bf16x8 av = *(const LAS bf16x8*)(pa + k * 2);
        const bf16x8 bv = *(const LAS bf16x8*)(pb + k * 2);
        acc = __builtin_amdgcn_mfma_f32_32x32x16_bf16(av, bv, acc, 0, 0, 0);
    }
}

DI bf16x8 tr_frag(const LAS unsigned char* T, int pitch, int k0, int c0, int lane) {
    const int h = lane >> 5, blk = (lane >> 4) & 1, q = (lane & 15) >> 2, p = lane & 3;
    const LAS unsigned char* a = T + (k0 + 8 * h + q) * pitch + (c0 + 16 * blk + 4 * p) * 2;
    const s16x4 lo = __builtin_amdgcn_ds_read_tr16_b64_v4i16((LAS s16x4*)a);
    const s16x4 hi = __builtin_amdgcn_ds_read_tr16_b64_v4i16((LAS s16x4*)(a + 4 * pitch));
    return __builtin_shufflevector(lo, hi, 0, 1, 2, 3, 4, 5, 6, 7);
}

constexpr int CM_PW = 272, CM_PV = 576, CM_PS = 528;
constexpr int CM_W = 0, CM_VN = 128 * CM_PW, CM_MU = CM_VN + 128 * CM_PV, CM_SO = CM_VN;
static_assert(CM_MU + 1024 <= RING_BYTES && 128 * CM_PS <= 128 * CM_PV, "chunk-MLP LDS map");
DI void p3a_chunk_mlp(const Args& a, LAS unsigned char* lds, int vcu, int G, int wave, int lane, int tid) {
    unsigned char* ws = a.ws;
    const bf16_t* GV = (const bf16_t*)(ws + WS_GV); bf16_t* GU = (bf16_t*)(ws + WS_GU);
    const float* stat = (const float*)(ws + WS_STAT);
    const float* lng = a.in[I_LNVG]; const float* lnb = a.in[I_LNVB]; const float* wsp = a.in[I_WS]; const float* bsp = a.in[I_BS];
    const int r = lane & 31, h = lane >> 5;
    for (int item = vcu; item < 512; item += G) {
        const int chunk = item >> 2, g = item & 3, row_base = chunk * 128;
        if (tid < 128) {
            const float* sp = stat + (size_t)(row_base + tid) * 32; float s = 0.f, q = 0.f;
#pragma unroll
            for (int k = 0; k < 8; ++k) { const f32x4 v = *(const f32x4*)(sp + 4 * k); s += v.x + v.z; q += v.y + v.w; }
            const float mu = s * (1.f / 1024.f); const float var = fmaxf(q * (1.f / 1024.f) - mu * mu, 0.f);
            *(LAS f32x2*)(lds + CM_MU + tid * 8) = (f32x2){mu, rsqrtf(var + EPS)};
        }
#pragma unroll
        for (int i = 0; i < 8; ++i) {
            const int e = (i * NTHR + tid) * 4, p = e >> 7, q = e & 127;
            const f32x4 w = *(const f32x4*)(wsp + (size_t)g * 16384 + e);
            *(LAS u32x2*)(lds + CM_W + p * CM_PW + q * 2) = (u32x2){pk2(w.x, w.y), pk2(w.z, w.w)};
        }
        __syncthreads();
        {
            const int c16 = tid & 31, ch = g * 256 + c16 * 8;
            const f32x4 g0 = *(const f32x4*)(lng + ch), g1 = *(const f32x4*)(lng + ch + 4), b0 = *(const f32x4*)(lnb + ch), b1 = *(const f32x4*)(lnb + ch + 4);
#pragma unroll
            for (int i = 0; i < 8; ++i) {
                const int q = i * 16 + (tid >> 5);
                const u32x4 gv = *(const u32x4*)(GV + (size_t)(row_base + q) * DM + ch);
                const f32x2 ms = *(const LAS f32x2*)(lds + CM_MU + q * 8);
                u32x4 w;
                w.x = pk2((bflo(gv.x) - ms.x) * ms.y * g0.x + b0.x, (bfhi(gv.x) - ms.x) * ms.y * g0.y + b0.y);
                w.y = pk2((bflo(gv.y) - ms.x) * ms.y * g0.z + b0.z, (bfhi(gv.y) - ms.x) * ms.y * g0.w + b0.w);
                w.z = pk2((bflo(gv.z) - ms.x) * ms.y * g1.x + b1.x, (bfhi(gv.z) - ms.x) * ms.y * g1.y + b1.y);
                w.w = pk2((bflo(gv.w) - ms.x) * ms.y * g1.z + b1.z, (bfhi(gv.w) - ms.x) * ms.y * g1.w + b1.w);
                *(LAS u32x4*)(lds + CM_VN + q * CM_PV + c16 * 16) = w;
            }
        }
        __syncthreads();
        f32x16 acc[4];
#pragma unroll
        for (int ti = 0; ti < 4; ++ti) for (int e = 0; e < 16; ++e) acc[ti][e] = 0.f;
#pragma unroll
        for (int ks = 0; ks < 8; ++ks) {
            const bf16x8 bv = tr_frag(lds + CM_VN, CM_PV, 16 * ks, wave * 32, lane);
#pragma unroll
            for (int ti = 0; ti < 4; ++ti) {
                const bf16x8 av = *(const LAS bf16x8*)(lds + CM_W + (ti * 32 + r) * CM_PW + (16 * ks + 8 * h) * 2);
                acc[ti] = __builtin_amdgcn_mfma_f32_32x32x16_bf16(av, bv, acc[ti], 0, 0, 0);
            }
        }
        __syncthreads();
        {
            const int c = wave * 32 + r;
#pragma unroll
            for (int ti = 0; ti < 4; ++ti)
#pragma unroll
                for (int e = 0; e < 16; ++e) { const int p = ti * 32 + crow(e, h); *(LAS bf16_t*)(lds + CM_SO + p * CM_PS + c * 2) = f2bf(acc[ti][e] + bsp[g * 128 + p]); }
        }
        __syncthreads();
        {
            const int c16 = tid & 31, ch = g * 256 + c16 * 8;
#pragma unroll
            for (int i = 0; i < 8; ++i) {
                const int p = i * 16 + (tid >> 5);
                const u32x4 sv = *(const LAS u32x4*)(lds + CM_SO + p * CM_PS + c16 * 16);
                bf16_t* up = GU + (size_t)(row_base + p) * DM + ch;
                const u32x4 uv = *(const u32x4*)up;
                u32x4 w;
                w.x = pk2(bflo(uv.x) * bflo(sv.x), bfhi(uv.x) * bfhi(sv.x)); w.y = pk2(bflo(uv.y) * bflo(sv.y), bfhi(uv.y) * bfhi(sv.y));
                w.z = pk2(bflo(uv.z) * bflo(sv.z), bfhi(uv.z) * bfhi(sv.z)); w.w = pk2(bflo(uv.w) * bflo(sv.w), bfhi(uv.w) * bfhi(sv.w));
                *(u32x4*)up = w;
            }
        }
        __syncthreads();
    }
}
DI void p3a_dec(const Args& a, int vcu, int G, int wave, int lane) {
    unsigned char* ws = a.ws;
    const bf16_t* H = (const bf16_t*)(ws + WS_H); const float* win = a.in[I_WIN] + 5120; float* dec = (float*)(ws + WS_DEC);
    const int gw = vcu * NWAVES + wave, NGW = G * NWAVES, j = lane & 31, hh = lane >> 5;
    for (int it = NGW - 1 - gw; it < MT / 4; it += NGW) {
        const int r0 = it * 4 + hh * 2;
        const bf16_t* h0 = H + (size_t)r0 * DM; const bf16_t* h1 = h0 + DM;
        float a0 = 0.f, a1 = 0.f;
        for (int c = 0; c < DM; c += 8) {
            const u32x4 x0 = *(const u32x4*)(h0 + c), x1 = *(const u32x4*)(h1 + c);
            const float* wp = win + (size_t)c * WIN_PITCH + j;
            const float w0 = wp[0], w1 = wp[WIN_PITCH], w2 = wp[2 * WIN_PITCH], w3 = wp[3 * WIN_PITCH], w4 = wp[4 * WIN_PITCH], w5 = wp[5 * WIN_PITCH], w6 = wp[6 * WIN_PITCH], w7 = wp[7 * WIN_PITCH];
            a0 += bflo(x0.x) * w0 + bfhi(x0.x) * w1 + bflo(x0.y) * w2 + bfhi(x0.y) * w3 + bflo(x0.z) * w4 + bfhi(x0.z) * w5 + bflo(x0.w) * w6 + bfhi(x0.w) * w7;
            a1 += bflo(x1.x) * w0 + bfhi(x1.x) * w1 + bflo(x1.y) * w2 + bfhi(x1.y) * w3 + bflo(x1.z) * w4 + bfhi(x1.z) * w5 + bflo(x1.w) * w6 + bfhi(x1.w) * w7;
        }
        dec[(size_t)r0 * 32 + j] = a0; dec[(size_t)(r0 + 1) * 32 + j] = a1;
    }
}

constexpr int GP_K = 272, GP_KP = 320, GP_V = 576, GP_A = 144;
constexpr int GL_QT = 0, GL_KT = GL_QT + 64 * GP_K, GL_KP = GL_KT + 64 * GP_K, GL_VR = GL_KP + 64 * GP_KP, GL_AT = GL_VR + 64 * GP_V,
              GL_DEC = GL_AT + 64 * GP_A, GL_GT = GL_DEC + 4096, GL_BL = GL_GT + 2048, GL_END = GL_BL + 512;
constexpr int GL_OS = 0, OS_P = 260;
static_assert(64 * OS_P * 4 <= GL_AT && GL_END <= RING_BYTES, "GLA LDS map");

struct GlaSrc { const bf16_t* q; const bf16_t* k; const bf16_t* v; const float* dec; };

template <int DIR, bool FULL>
DI float gla_prep(LAS unsigned char* lds, const GlaSrc& s, const float* wdp, float bd, int tid_) {
    int tid = opaque(tid_);
#pragma unroll
    for (int i = 0; i < 2; ++i) { const int e = i * NTHR + tid, t = e >> 4, c16 = e & 15;
        *(LAS u32x4*)(lds + GL_KT + t * GP_K + c16 * 16) = *(const u32x4*)(s.k + (size_t)t * 512 + c16 * 8);
        if (FULL) *(LAS u32x4*)(lds + GL_QT + t * GP_K + c16 * 16) = *(const u32x4*)(s.q + (size_t)t * 512 + c16 * 8); }
#pragma unroll
    for (int i = 0; i < 4; ++i) { const int e = i * NTHR + tid, t = e >> 5, c16 = e & 31;
        *(LAS u32x4*)(lds + GL_VR + t * GP_V + c16 * 16) = *(const u32x4*)(s.v + (size_t)t * 1024 + c16 * 8); }
    if (tid < 256) { const int t = tid >> 2, r4 = (tid & 3) * 4; *(LAS f32x4*)(lds + GL_DEC + (t * 16 + r4) * 4) = *(const f32x4*)(s.dec + (size_t)t * 32 + r4); }
    __syncthreads();
    tid = opaque(tid_);
    const int kd = tid & 127, tg = tid >> 7;
    float c[16];
#pragma unroll
    for (int i = 0; i < 16; ++i) c[i] = bd;
#pragma unroll
    for (int r4 = 0; r4 < 4; ++r4) {
        const float w0 = wdp[(r4 * 4 + 0) * 512 + kd], w1 = wdp[(r4 * 4 + 1) * 512 + kd], w2 = wdp[(r4 * 4 + 2) * 512 + kd], w3 = wdp[(r4 * 4 + 3) * 512 + kd];
#pragma unroll
        for (int i = 0; i < 16; ++i) { const f32x4 d = *(const LAS f32x4*)(lds + GL_DEC + ((tg * 16 + i) * 16 + r4 * 4) * 4); c[i] += d.x * w0 + d.y * w1 + d.z * w2 + d.w * w3; }
    }
#pragma unroll
    for (int i = 0; i < 16; ++i) {
        const float z = c[i], e = __builtin_amdgcn_exp2f(-1.4426950408889634f * fabsf(z));
        c[i] = (fminf(z, 0.f) - 0.6931471805599453f * __builtin_amdgcn_logf(1.f + e)) * (1.f / 16.f);
    }
    if (DIR == 0) {
#pragma unroll
        for (int i = 1; i < 16; ++i) c[i] += c[i - 1];
        *(LAS float*)(lds + GL_GT + (tg * 128 + kd) * 4) = c[15];
    } else {
#pragma unroll
        for (int i = 14; i >= 0; --i) c[i] += c[i + 1];
        *(LAS float*)(lds + GL_GT + (tg * 128 + kd) * 4) = c[0];
    }
    __syncthreads();
    float off = 0.f, total = 0.f;
#pragma unroll
    for (int g = 0; g < 4; ++g) { const float gt = *(const LAS float*)(lds + GL_GT + (g * 128 + kd) * 4); total += gt; if (DIR == 0 ? (g < tg) : (g > tg)) off += gt; }
#pragma unroll
    for (int i = 0; i < 16; ++i) {
        const int t = tg * 16 + i; const float b = c[i] + off;
        LAS bf16_t* kp = (LAS bf16_t*)(lds + GL_KT + t * GP_K + kd * 2);
        const float kx = bf2f(*kp);
        *(LAS bf16_t*)(lds + GL_KP + t * GP_KP + kd * 2) = f2bf(kx * __builtin_amdgcn_exp2f(1.4426950408889634f * (total - b)));
        if (FULL) {
            LAS bf16_t* qp = (LAS bf16_t*)(lds + GL_QT + t * GP_K + kd * 2);
            const float qx = bf2f(*qp);
            *qp = f2bf(qx * __builtin_amdgcn_exp2f(1.4426950408889634f * b));
            *kp = f2bf(kx * __builtin_amdgcn_exp2f(-1.4426950408889634f * b));
        }
    }
    if (tg == 0) *(LAS float*)(lds + GL_BL + kd * 4) = __builtin_amdgcn_exp2f(1.4426950408889634f * total);
    __syncthreads();
    return total;
}
DI void gla_update_state(f32x16 (&S)[4], const bf16x8 (&vf)[4], LAS unsigned char* lds, int lane) {
    const int h = lane >> 5;
#pragma unroll
    for (int m = 0; m < 4; ++m) {
#pragma unroll
        for (int g = 0; g < 4; ++g) {
            const f32x4 gm = *(const LAS f32x4*)(lds + GL_BL + (m * 32 + 8 * g + 4 * h) * 4);
            S[m][4 * g] *= gm.x; S[m][4 * g + 1] *= gm.y; S[m][4 * g + 2] *= gm.z; S[m][4 * g + 3] *= gm.w;
        }
#pragma unroll
        for (int ks = 0; ks < 4; ++ks) {
            const bf16x8 av = tr_frag(lds + GL_KP, GP_KP, 16 * ks, 32 * m, lane);
            S[m] = __builtin_amdgcn_mfma_f32_32x32x16_bf16(av, vf[ks], S[m], 0, 0, 0);
        }
    }
}
DI bf16x8 pack_step(const f32x16& x, int s) {
    u32x4 p; p.x = pk2(x[8 * s], x[8 * s + 1]); p.y = pk2(x[8 * s + 2], x[8 * s + 3]); p.z = pk2(x[8 * s + 4], x[8 * s + 5]); p.w = pk2(x[8 * s + 6], x[8 * s + 7]);
    return __builtin_bit_cast(bf16x8, p);
}
DI void gla_pass1(const Args& a, LAS unsigned char* lds, int vcu, int G, int wave, int lane, int tid) {
    unsigned char* ws = a.ws;
    for (int item = vcu; item < 16 * NSC; item += G) {
        const int chain = item >> 5, slot = item & 31, b = chain >> 3, hd = (chain >> 1) & 3, dir = chain & 1;
        const bf16_t *kb, *vb; const float* db;
        if (slot == 0) { kb = (const bf16_t*)(ws + WS_KC) + (size_t)(b * CTXL) * 512 + hd * 128; vb = (const bf16_t*)(ws + WS_VC) + (size_t)(b * CTXL) * 1024 + hd * 256; db = (const float*)(ws + WS_DEC) + (size_t)(M + b * CTXL) * 32 + dir * 16; }
        else { const int j = dir == 0 ? slot - 1 : 32 - slot; const size_t r0 = (size_t)b * SEQ + (size_t)j * 256;
            kb = (const bf16_t*)(ws + WS_K) + r0 * 512 + hd * 128; vb = (const bf16_t*)(ws + WS_V) + r0 * 1024 + hd * 256; db = (const float*)(ws + WS_DEC) + r0 * 32 + dir * 16; }
        const float* wdp = a.in[I_WDEC2] + (size_t)dir * 16 * 512 + hd * 128;
        const float bd = a.in[I_BDEC][dir * 512 + hd * 128 + (tid & 127)];
        f32x16 S[4];
#pragma unroll
        for (int m = 0; m < 4; ++m) for (int e = 0; e < 16; ++e) S[m][e] = 0.f;
        float gtot = 0.f;
#pragma unroll 1
        for (int cc = 0; cc < 4; ++cc) {
            const int c = dir == 0 ? cc : 3 - cc;
            GlaSrc s; s.q = nullptr; s.k = kb + (size_t)c * 64 * 512; s.v = vb + (size_t)c * 64 * 1024; s.dec = db + (size_t)c * 64 * 32;
            if (dir == 0) gtot += gla_prep<0, false>(lds, s, wdp, bd, tid); else gtot += gla_prep<1, false>(lds, s, wdp, bd, tid);
            bf16x8 vf[4];
#pragma unroll
            for (int ks = 0; ks < 4; ++ks) vf[ks] = tr_frag(lds + GL_VR, GP_V, 16 * ks, wave * 32, lane);
            gla_update_state(S, vf, lds, lane);
            __syncthreads();
        }
        bf16_t* st = (bf16_t*)(ws + WS_ST) + ((size_t)chain * 33 + slot) * 32768;
        { const __amdgpu_buffer_rsrc_t rs = __builtin_amdgcn_make_buffer_rsrc(st, 0, 65536, 0x00020000);
          const unsigned vo = (unsigned)((4 * (lane >> 5)) * 256 + wave * 32 + (lane & 31)) * 2u;
#pragma unroll
          for (int m = 0; m < 4; ++m)
#pragma unroll
              for (int r = 0; r < 16; ++r) __builtin_amdgcn_raw_buffer_store_b16(f2bf(S[m][r]), rs, vo, (m * 32 + crow(r, 0)) * 512, 0); }
        if (tid < 128) ((float*)(ws + WS_GAM))[((size_t)chain * 33 + slot) * 128 + tid] = __builtin_amdgcn_exp2f(1.4426950408889634f * gtot);
    }
}
DI void gla_pass2(const Args& a, int vcu, int G, int tid) {
    unsigned char* ws = a.ws;
    const float* gam = (const float*)(ws + WS_GAM);
    for (int e = vcu * NTHR + tid; e < 16 * 128 * 64; e += G * NTHR) {
        const int chain = e >> 13, kd = (e >> 6) & 127, n4 = e & 63;
        u32x2* st = (u32x2*)((bf16_t*)(ws + WS_ST) + (size_t)chain * 33 * 32768 + (size_t)kd * 256 + n4 * 4);
        float s0 = 0.f, s1 = 0.f, s2 = 0.f, s3 = 0.f;
        u32x2 d = st[0];
        for (int slot = 0; slot < 32; ++slot) {
            const float gm = gam[((size_t)chain * 33 + slot) * 128 + kd];
            const u32x2 dn = (slot < 31) ? st[(size_t)(slot + 1) * 8192] : d;
            if (slot > 0) st[(size_t)slot * 8192] = (u32x2){pk2(s0, s1), pk2(s2, s3)};
            s0 = gm * s0 + bflo(d.x); s1 = gm * s1 + bfhi(d.x); s2 = gm * s2 + bflo(d.y); s3 = gm * s3 + bfhi(d.y);
            d = dn;
        }
        st[(size_t)32 * 8192] = (u32x2){pk2(s0, s1), pk2(s2, s3)};
    }
}
template <int DIR>
DI void gla_chunk_out(f32x16 (&S)[4], LAS unsigned char* lds, int wave, int lane_) {
    int lane = opaque(lane_);
    int r = lane & 31, h = lane >> 5;
    if (wave < 4) {
        const int ti = wave >> 1, tj = wave & 1;
        f32x16 at; for (int e = 0; e < 16; ++e) at[e] = 0.f;
#pragma unroll
        for (int ks = 0; ks < 8; ++ks) {
            const bf16x8 av = *(const LAS bf16x8*)(lds + GL_QT + (ti * 32 + r) * GP_K + (16 * ks + 8 * h) * 2);
            const bf16x8 bv = *(const LAS bf16x8*)(lds + GL_KT + (tj * 32 + r) * GP_K + (16 * ks + 8 * h) * 2);
            at = __builtin_amdgcn_mfma_f32_32x32x16_bf16(av, bv, at, 0, 0, 0);
        }
        const int j = tj * 32 + r;
#pragma unroll
        for (int e = 0; e < 16; ++e) {
            const int i = ti * 32 + crow(e, h);
            const bool keep = DIR == 0 ? (j <= i) : (j >= i);
            *(LAS bf16_t*)(lds + GL_AT + i * GP_A + j * 2) = f2bf(keep ? at[e] : 0.f);
        }
    }
    bf16x8 vf[4];
#pragma unroll
    for (int ks = 0; ks < 4; ++ks) vf[ks] = tr_frag(lds + GL_VR, GP_V, 16 * ks, wave * 32, lane);
    __syncthreads();
    f32x16 o[2];
#pragma unroll
    for (int ti = 0; ti < 2; ++ti) {
        for (int e = 0; e < 16; ++e) o[ti][e] = 0.f;
#pragma unroll
        for (int ks = 0; ks < 4; ++ks) {
            const bf16x8 av = *(const LAS bf16x8*)(lds + GL_AT + (ti * 32 + r) * GP_A + (16 * ks + 8 * h) * 2);
            o[ti] = __builtin_amdgcn_mfma_f32_32x32x16_bf16(av, vf[ks], o[ti], 0, 0, 0);
        }
    }
#pragma unroll
    for (int m = 0; m < 4; ++m)
#pragma unroll
        for (int s = 0; s < 2; ++s) {
            const bf16x8 bs = pack_step(S[m], s);
#pragma unroll
            for (int ti = 0; ti < 2; ++ti) {
                const LAS unsigned char* qp = lds + GL_QT + (ti * 32 + r) * GP_K + (m * 32 + 16 * s + 4 * h) * 2;
                const s16x4 lo = *(const LAS s16x4*)qp, hi = *(const LAS s16x4*)(qp + 16);
                const bf16x8 av = __builtin_shufflevector(lo, hi, 0, 1, 2, 3, 4, 5, 6, 7);
                o[ti] = __builtin_amdgcn_mfma_f32_32x32x16_bf16(av, bs, o[ti], 0, 0, 0);
            }
        }
    gla_update_state(S, vf, lds, lane);
    __syncthreads();
    lane = opaque(lane_); r = lane & 31; h = lane >> 5;
    {
        const int n = wave * 32 + r;
#pragma unroll
        for (int ti = 0; ti < 2; ++ti)
#pragma unroll
            for (int e = 0; e < 16; ++e) *(LAS float*)(lds + GL_OS + ((ti * 32 + crow(e, h)) * OS_P + n) * 4) = o[ti][e];
    }
    __syncthreads();
}
DI void gla_load_state(f32x16 (&S)[4], const bf16_t* st, int wave, int lane) {
    const __amdgpu_buffer_rsrc_t rs = __builtin_amdgcn_make_buffer_rsrc((void*)st, 0, 65536, 0x00020000);
    const unsigned vo = (unsigned)((4 * (lane >> 5)) * 256 + wave * 32 + (lane & 31)) * 2u;
#pragma unroll
    for (int m = 0; m < 4; ++m)
#pragma unroll
        for (int r = 0; r < 16; ++r) S[m][r] = bf2f(__builtin_amdgcn_raw_buffer_load_b16(rs, vo, (m * 32 + crow(r, 0)) * 512, 0));
}
DI void gla_pass3(const Args& a, LAS unsigned char* lds, int vcu, int G, int wave, int lane, int tid) {
    unsigned char* ws = a.ws;
    const float* ong = a.in[I_ONG];
    for (int item = vcu; item < 8 * NSC; item += G) {
        const int b = item >> 7, hd = (item >> 5) & 3, j = item & 31;
        const size_t r0 = (size_t)b * SEQ + (size_t)j * 256;
#pragma unroll 1
        for (int dir = 0; dir < 2; ++dir) {
            const int chain = (b * 4 + hd) * 2 + dir;
            const float* wdp = a.in[I_WDEC2] + (size_t)dir * 16 * 512 + hd * 128;
            const float bd = a.in[I_BDEC][dir * 512 + hd * 128 + (tid & 127)];
            f32x16 S[4];
            gla_load_state(S, (const bf16_t*)(ws + WS_ST) + ((size_t)chain * 33 + (dir == 0 ? j + 1 : 32 - j)) * 32768, wave, lane);
#pragma unroll 1
            for (int cc = 0; cc < 4; ++cc) {
                const int c = dir == 0 ? cc : 3 - cc;
                const size_t rc = r0 + (size_t)c * 64;
                GlaSrc s; s.q = (const bf16_t*)(ws + WS_Q) + rc * 512 + hd * 128; s.k = (const bf16_t*)(ws + WS_K) + rc * 512 + hd * 128;
                s.v = (const bf16_t*)(ws + WS_V) + rc * 1024 + hd * 256; s.dec = (const float*)(ws + WS_DEC) + rc * 32 + dir * 16;
                if (dir == 0) { gla_prep<0, true>(lds, s, wdp, bd, tid); gla_chunk_out<0>(S, lds, wave, lane); }
                else { gla_prep<1, true>(lds, s, wdp, bd, tid); gla_chunk_out<1>(S, lds, wave, lane); }
                const int tid2 = opaque(tid), row = tid2 >> 3, seg = tid2 & 7;
                bf16_t* ofp = (bf16_t*)(ws + WS_OF) + (rc + row) * 1024 + hd * 256 + seg * 32;
                const LAS unsigned char* osp = lds + GL_OS + (row * OS_P + seg * 32) * 4;
                if (dir == 0) {
#pragma unroll
                    for (int q8 = 0; q8 < 4; ++q8) { const f32x4 x0 = *(const LAS f32x4*)(osp + q8 * 32), x1 = *(const LAS f32x4*)(osp + q8 * 32 + 16);
                        u32x4 w; w.x = pk2(x0.x, x0.y); w.y = pk2(x0.z, x0.w); w.z = pk2(x1.x, x1.y); w.w = pk2(x1.z, x1.w); *(u32x4*)(ofp + q8 * 8) = w; }
                } else {
                    float ov[32]; float ss = 0.f;
#pragma unroll
                    for (int q8 = 0; q8 < 4; ++q8) { const f32x4 x0 = *(const LAS f32x4*)(osp + q8 * 32), x1 = *(const LAS f32x4*)(osp + q8 * 32 + 16); const u32x4 w = *(const u32x4*)(ofp + q8 * 8);
                        ov[q8 * 8] = x0.x + bflo(w.x); ov[q8 * 8 + 1] = x0.y + bfhi(w.x); ov[q8 * 8 + 2] = x0.z + bflo(w.y); ov[q8 * 8 + 3] = x0.w + bfhi(w.y);
                        ov[q8 * 8 + 4] = x1.x + bflo(w.z); ov[q8 * 8 + 5] = x1.y + bfhi(w.z); ov[q8 * 8 + 6] = x1.z + bflo(w.w); ov[q8 * 8 + 7] = x1.w + bfhi(w.w); }
#pragma unroll
                    for (int e = 0; e < 32; ++e) ss += ov[e] * ov[e];
                    ss += __shfl_xor(ss, 1); ss += __shfl_xor(ss, 2); ss += __shfl_xor(ss, 4);
                    const float rs = rsqrtf(ss * (1.f / 256.f) + EPS);
                    bf16_t* rp = (bf16_t*)(ws + WS_R) + (rc + row) * 1024 + hd * 256 + seg * 32; const float* gp = ong + hd * 256 + seg * 32;
#pragma unroll
                    for (int q8 = 0; q8 < 4; ++q8) {
                        const u32x4 rv = *(const u32x4*)(rp + q8 * 8); const f32x4 g0 = *(const f32x4*)(gp + q8 * 8), g1 = *(const f32x4*)(gp + q8 * 8 + 4);
                        u32x4 w;
                        w.x = pk2(ov[q8 * 8] * rs * g0.x * bflo(rv.x), ov[q8 * 8 + 1] * rs * g0.y * bfhi(rv.x)); w.y = pk2(ov[q8 * 8 + 2] * rs * g0.z * bflo(rv.y), ov[q8 * 8 + 3] * rs * g0.w * bfhi(rv.y));
                        w.z = pk2(ov[q8 * 8 + 4] * rs * g1.x * bflo(rv.z), ov[q8 * 8 + 5] * rs * g1.y * bfhi(rv.z)); w.w = pk2(ov[q8 * 8 + 6] * rs * g1.z * bflo(rv.w), ov[q8 * 8 + 7] * rs * g1.w * bfhi(rv.w));
                        *(u32x4*)(rp + q8 * 8) = w;
                    }
                }
                __syncthreads();
            }
            VM_WAIT();
            __syncthreads();
        }
    }
}

__global__ void __launch_bounds__(NTHR, 2) fwd_kernel(Args args) {
    extern __shared__ __attribute__((aligned(16))) unsigned char lds_raw[];
    LAS unsigned char* lds = (LAS unsigned char*)lds_raw;
    volatile LAS unsigned* MISC = (volatile LAS unsigned*)(lds + MISC_OFF);
    const int tid = threadIdx.x, lane = tid & 63, wave = __builtin_amdgcn_readfirstlane(tid >> 6);
    const int G = gridDim.x; const int bx = blockIdx.x; const int vcu = (G % 8 == 0) ? (bx % 8) * (G / 8) + bx / 8 : bx;
    unsigned char* ws = args.ws;
    for (int u = tid; u < (LDS_BYTES - LDSCTL_OFF) / 4; u += NTHR) ((LAS unsigned*)(lds + LDSCTL_OFF))[u] = 0u;
    __syncthreads();
    XcdBarrier bar = xcd_barrier_post((unsigned*)(ws + WS_CTL) + CW_BAR, MISC + 8);
#define GRID_BAR() xcd_barrier(bar)

    p0_prologue(args, lds, vcu, G, wave, opaque(tid) & 63);
    GRID_BAR();
    { const int t_ = opaque(tid); p1_rows(args, lds, vcu, G, wave, t_ & 63, t_); }
    GRID_BAR();
    {
        pg8::Gemm g; g.A0 = (const bf16_t*)(ws + WS_H); g.A1 = (const bf16_t*)(ws + WS_H) + (size_t)M * DM; g.B0 = g.B1 = (const bf16_t*)(ws + WS_WIN); g.lda = DM; g.ldb = DM; g.K = DM;
        SchedP2 S{G, bx}; EpiZ E{ws, (bf16_t*)args.out};
        pg8::gemm_phase<EpiZ, SchedP2, true>(lds, g, S, E);
    }
    GRID_BAR();
    { const int t_ = opaque(tid); p3a_chunk_mlp(args, lds, vcu, G, wave, t_ & 63, t_); }
    p3a_dec(args, vcu, G, wave, opaque(tid) & 63);
    GRID_BAR();
    { const int t_ = opaque(tid); gla_pass1(args, lds, vcu, G, wave, t_ & 63, t_); }
    GRID_BAR();
    gla_pass2(args, vcu, G, opaque(tid));
    GRID_BAR();
    { const int t_ = opaque(tid); gla_pass3(args, lds, vcu, G, wave, t_ & 63, t_); }
    GRID_BAR();
    {
        pg8::Gemm g; g.A0 = (const bf16_t*)(ws + WS_GU); g.A1 = (const bf16_t*)(ws + WS_R); g.B0 = (const bf16_t*)(ws + WS_PA); g.B1 = (const bf16_t*)(ws + WS_PB); g.lda = DM; g.ldb = DM; g.K = DM;
        SchedMerge S{G, bx}; EpiMerge E{(bf16_t*)(ws + WS_MG), (const bf16_t*)args.out};
        pg8::gemm_phase<EpiMerge, SchedMerge, true>(lds, g, S, E);
    }
    GRID_BAR();
    {
        pg8::Gemm g; g.A0 = g.A1 = (const bf16_t*)(ws + WS_MG); g.B0 = g.B1 = (const bf16_t*)(ws + WS_WO); g.lda = DM; g.ldb = DM; g.K = DM;
        pg8::StaticOrder S; S.init(M, DM, G, bx); EpiRes1 E{args.in[I_X], (const float*)(ws + WS_POS), (const float*)(ws + WS_MODF), args.out};
        pg8::gemm_phase<EpiRes1, pg8::StaticOrder, false>(lds, g, S, E);
    }
    GRID_BAR();
    p5c_rows(args, vcu, G, wave, opaque(tid) & 63);
    GRID_BAR();
    {
        pg8::Gemm g; g.A0 = g.A1 = (const bf16_t*)(ws + WS_H); g.B0 = g.B1 = (const bf16_t*)(ws + WS_W1); g.lda = DM; g.ldb = DM; g.K = DM;
        pg8::StaticOrder S; S.init(M, DFF, G, bx); EpiFF1 E{(bf16_t*)(ws + WS_T)};
        pg8::gemm_phase<EpiFF1, pg8::StaticOrder, true>(lds, g, S, E);
    }
    GRID_BAR();
    {
        pg8::Gemm g; g.A0 = g.A1 = (const bf16_t*)(ws + WS_T); g.B0 = g.B1 = (const bf16_t*)(ws + WS_W2); g.lda = DFF; g.ldb = DFF; g.K = DFF;
        pg8::StaticOrder S; S.init(M, DM, G, bx); EpiRes2 E{(const float*)(ws + WS_MODF), args.out};
        pg8::gemm_phase<EpiRes2, pg8::StaticOrder, false>(lds, g, S, E);
    }
    GRID_BAR();
    p7_rows(args, vcu, G, wave, opaque(tid) & 63);
}

extern "C" void kernel_launch(void* const* d_in, const int* in_sizes, int n_in, void* d_out, int out_size, void* d_ws, size_t ws_size, hipStream_t stream) {
    static int grid = 0;
    if (grid == 0) {
        if (n_in != 22 || out_size != M * DM || ws_size < WS_END) { fprintf(stderr, "kernel_launch: unexpected shapes (n_in %d out %d ws %zu)\n", n_in, out_size, ws_size); grid = -1; return; }
        int dev = 0, cus = 0, per_cu = 0;
        if (hipGetDevice(&dev) != hipSuccess || hipDeviceGetAttribute(&cus, hipDeviceAttributeMultiprocessorCount, dev) != hipSuccess) { grid = -1; return; }
        if (hipFuncSetAttribute((const void*)fwd_kernel, hipFuncAttributeMaxDynamicSharedMemorySize, LDS_BYTES) != hipSuccess) { fprintf(stderr, "kernel_launch: hipFuncSetAttribute failed\n"); grid = -1; return; }
        if (hipOccupancyMaxActiveBlocksPerMultiprocessor(&per_cu, (const void*)fwd_kernel, NTHR, LDS_BYTES) != hipSuccess || per_cu < 1) { fprintf(stderr, "kernel_launch: occupancy query says %d\n", per_cu); (void)hipGetLastError(); per_cu = 1; }
        grid = cus;
    }
    if (grid < 0) return;
    (void)hipMemsetAsync((char*)d_ws + WS_CTL, 0, CTL_ZERO_BYTES, stream);
    Args a{};
    for (int i = 0; i < 22; ++i) a.in[i] = (const float*)d_in[i];
    a.out = (float*)d_out; a.ws = (unsigned char*)d_ws;
    hipLaunchKernelGGL(fwd_kernel, dim3(grid), dim3(NTHR), LDS_BYTES, stream, a);
}
```

```cpp
#include <hip/hip_runtime.h>
#include <cstdio>
#include <cstdint>

#define LAS __attribute__((address_space(3)))
#define GAS __attribute__((address_space(1)))
typedef unsigned short bf16_t;
typedef short bf16x8 __attribute__((ext_vector_type(8)));
typedef short s16x4 __attribute__((ext_vector_type(4)));
typedef float f32x2 __attribute__((ext_vector_type(2)));
typedef float f32x4 __attribute__((ext_vector_type(4)));
typedef float f32x16 __attribute__((ext_vector_type(16)));
typedef unsigned u32x2 __attribute__((ext_vector_type(2)));
typedef unsigned u32x4 __attribute__((ext_vector_type(4)));
typedef __bf16 bf16x2_t __attribute__((ext_vector_type(2)));
#define DI __device__ __forceinline__
#ifndef REPEAT_MASK
#define REPEAT_MASK 0
#endif
#ifndef STAMP_A
#define STAMP_A -1
#define STAMP_B -1
#endif
#ifndef PHASE_MASK
#define PHASE_MASK 0xFFFF
#endif
#if REPEAT_MASK
#define REP(k) if constexpr ((PHASE_MASK >> (k)) & 1) for (int rep_ = 0; rep_ < 1 + ((REPEAT_MASK >> (k)) & 1); ++rep_)
#else
#define REP(k) if constexpr ((PHASE_MASK >> (k)) & 1)
#endif

constexpr int DM = 1024, NB = 2, SEQ = 8192, M = NB * SEQ, CTXL = 256, MC = NB * CTXL, MT = M + MC, DFF = 4096;
constexpr int NZ = 7168;
constexpr int WIN_PITCH = 7200;
constexpr int NHEAD = 4, DK = 128, DV = 256, RANK = 16;
constexpr int NSC = 32;
constexpr float EPS = 1e-6f;

constexpr size_t MiB = 1u << 20;
constexpr size_t WS_CTL = 0, CTL_ZERO_BYTES = 1 * MiB;
constexpr size_t WS_POS = 1 * MiB;
constexpr size_t WS_MODP = 2 * MiB;
constexpr size_t WS_DEC = 3 * MiB;
constexpr size_t WS_MODF = 5 * MiB + 512 * 1024;
constexpr size_t WS_STAT = 6 * MiB;
constexpr size_t WS_WIN = 8 * MiB;
constexpr size_t WS_PA = 23 * MiB, WS_PB = 25 * MiB, WS_WO = 27 * MiB, WS_W1 = 29 * MiB, WS_W2 = 37 * MiB;
constexpr size_t WS_H = 45 * MiB;
constexpr size_t WS_GU = 78 * MiB, WS_GV = 110 * MiB, WS_Q = 142 * MiB, WS_K = 158 * MiB, WS_V = 174 * MiB, WS_R = 206 * MiB;
constexpr size_t WS_KC = 238 * MiB, WS_VC = 238 * MiB + 512 * 1024;
constexpr size_t WS_GAM = 240 * MiB;
constexpr size_t WS_END = 241 * MiB;
constexpr size_t WS_ST = WS_H;
constexpr size_t WS_OF = WS_GV;
constexpr size_t WS_MG = WS_Q;
constexpr size_t WS_T = WS_GU;
constexpr int CW_BAR = 4096;

constexpr int RING_BYTES = 131072, LDS_BYTES = 163840, LDSCTL_OFF = LDS_BYTES - 512, MISC_OFF = LDSCTL_OFF + 320;
constexpr int SILU_OFF = RING_BYTES + 1024;
constexpr int NWAVES = 8, NTHR = 512;

DI unsigned pk2(float lo, float hi) { f32x2 v = {lo, hi}; bf16x2_t b = __builtin_convertvector(v, bf16x2_t); return __builtin_bit_cast(unsigned, b); }
DI float bflo(unsigned w) { return __uint_as_float(w << 16); }
DI float bfhi(unsigned w) { return __uint_as_float(w & 0xffff0000u); }
DI float bf2f(bf16_t b) { return __uint_as_float(((unsigned)b) << 16); }
DI bf16_t f2bf(float f) { return (bf16_t)(pk2(f, 0.f) & 0xffffu); }
DI float sigm(float x) { return __builtin_amdgcn_rcpf(1.f + __builtin_amdgcn_exp2f(-1.4426950408889634f * x)); }
DI float wave_sum(float v) {
#pragma unroll
    for (int o = 1; o < 64; o <<= 1) v += __shfl_xor(v, o);
    return v;
}
DI int opaque(int x) { asm volatile("" : "+v"(x)); return x; }
#define LDS_WAIT() asm volatile("s_waitcnt lgkmcnt(0)" ::: "memory")
#define VM_WAIT() asm volatile("s_waitcnt vmcnt(0)" ::: "memory")

namespace pg8 {
constexpr int BM = 256, BK = 64, HALF = 128, HTB = HALF * BK * 2, STAGE_BYTES = 8 * HTB, NXCD = 8, WGM = 8;
__host__ __device__ __forceinline__ int lds_byte(int r, int c) { const int st = (r >> 4) * 2 + (c >> 5), rr = r & 15, cc = c & 31, ob = rr * 64 + cc * 2; return st * 1024 + (ob ^ (((ob >> 9) & 1) << 5)); }
__host__ __device__ __forceinline__ void stage_rc(int b, int& R, int& C) { const int st = b / 1024, sb = b % 1024, swz = sb ^ (((sb >> 9) & 1) << 5); R = (st >> 1) * 16 + swz / 64; C = (st & 1) * 32 + (swz % 64) / 2; }
__host__ __device__ __forceinline__ int perm32(int rho) { const int n = rho >> 4, i = rho & 15; return 8 * (i >> 2) + 4 * n + (i & 3); }

struct Unit { int pm, pn, sel; };
DI Unit unit_decode(int code) { Unit u; u.pm = code & 255; u.pn = (code >> 8) & 255; u.sel = (code >> 16) & 1; return u; }
struct Gemm { const bf16_t* A0; const bf16_t* A1; const bf16_t* B0; const bf16_t* B1; int lda, ldb, K; };

DI void tile_order(int L, int nM, int nN, int& pm, int& pn) {
    const int nwg = nM * nN; int wgid = L;
    { const int q = nwg / NXCD, r = nwg % NXCD, xcd = wgid % NXCD, off = wgid / NXCD; wgid = (xcd < r ? xcd * (q + 1) : r * (q + 1) + (xcd - r) * q) + off; }
    const int nig = WGM * nN, gid = wgid / nig, fm = gid * WGM, gsz = (nM - fm) < WGM ? (nM - fm) : WGM;
    pm = fm + ((wgid % nig) % gsz); pn = (wgid % nig) / gsz;
}
struct StaticOrder {
    int nM, nN, nwg, G, c;
    DI void init(int M_, int N_, int G_, int c_) { nM = M_ / BM; nN = N_ / BM; nwg = nM * nN; G = G_; c = c_; }
    DI int next(int i) const { const long L = (long)i * G + c; if (L >= nwg) return -1; int pm, pn; tile_order((int)L, nM, nN, pm, pn); return pm | (pn << 8); }
};

template <class Epi, class Sched, bool ALIGN_EPI>
DI void gemm_phase(LAS unsigned char* lds, const Gemm g, const Sched& S, const Epi& E) {
    const int tid = threadIdx.x, wid = __builtin_amdgcn_readfirstlane(tid >> 6), lane = tid & 63, wr = wid >> 2, wc = wid & 3, fr = lane & 15, fq = lane >> 4;
    const int nt = g.K / BK;
    unsigned voffA[2], voffB[2]; int aoff, boff;
#define PG8_LANE_CONSTS() do { const int t_ = opaque(tid); const int l_ = t_ & 63; \
        _Pragma("unroll") for (int i = 0; i < 2; ++i) { int R, C; stage_rc(t_ * 16 + i * 8192, R, C); const int Rb = Epi::PERM ? ((R & ~31) + perm32(R & 31)) : R; \
            voffA[i] = (unsigned)(R * g.lda + C) * 2u; voffB[i] = (unsigned)(Rb * g.ldb + C) * 2u; } \
        aoff = lds_byte(wr * 64 + (l_ & 15), (l_ >> 4) * 8); boff = lds_byte(wc * 32 + (l_ & 15), (l_ >> 4) * 8); } while (0)
    PG8_LANE_CONSTS();
    const size_t kstep = (size_t)(BK * 2);
    const size_t hstepA = (size_t)HALF * g.lda * 2, hstepB = (size_t)HALF * g.ldb * 2;
    const size_t tstepA = 2 * hstepA, tstepB = 2 * hstepB;
    const unsigned ldsw = (unsigned)wid * 1024u;
#define PG8_SA(b, h) (((b) * 2 + (h)) * HTB)
#define PG8_SB(b, h) ((4 + (b) * 2 + (h)) * HTB)
#define PG8_STAGE(bufoff, gbase, voff) do { _Pragma("unroll") for (int _i = 0; _i < 2; ++_i) \
        __builtin_amdgcn_global_load_lds((const unsigned*)((const char*)(gbase) + (voff)[_i]), (LAS unsigned*)(lds + (bufoff) + ldsw + _i * 8192), 16, 0, 0); } while (0)
#define PG8_LDA(dst, b, h) do { _Pragma("unroll") for (int m = 0; m < 4; ++m) _Pragma("unroll") for (int k = 0; k < 2; ++k) dst[m][k] = *(const LAS bf16x8*)(lds + PG8_SA(b, h) + aoff + m * 2048 + k * 1024); } while (0)
#define PG8_LDB(dst, b, h) do { _Pragma("unroll") for (int n = 0; n < 2; ++n) _Pragma("unroll") for (int k = 0; k < 2; ++k) dst[n][k] = *(const LAS bf16x8*)(lds + PG8_SB(b, h) + boff + n * 2048 + k * 1024); } while (0)
#define PG8_MMA(ai, bj, At, Bt) do { __builtin_amdgcn_s_setprio(1); _Pragma("unroll") for (int m = 0; m < 4; ++m) _Pragma("unroll") for (int n = 0; n < 2; ++n) _Pragma("unroll") for (int k = 0; k < 2; ++k) \
        acc[ai][bj][m][n] = __builtin_amdgcn_mfma_f32_16x16x32_bf16(Bt[n][k], At[m][k], acc[ai][bj][m][n], 0, 0, 0); __builtin_amdgcn_s_setprio(0); } while (0)
#define PG8_WAIT_V(n) asm volatile("s_waitcnt vmcnt(" #n ")" ::: "memory")
#define PG8_WAIT_L(n) asm volatile("s_waitcnt lgkmcnt(" #n ")" ::: "memory")
#define PG8_BAR __builtin_amdgcn_s_barrier()
#define PG8_SCHED __builtin_amdgcn_sched_barrier(0)
    int ui = 0;
    const int cu0 = S.next(0);
    if (cu0 < 0) return;
    Unit cur = unit_decode(cu0), nxt = cur;
    f32x4 acc[2][2][4][2];
#pragma unroll
    for (int a = 0; a < 2; ++a)
#pragma unroll
        for (int b = 0; b < 2; ++b)
#pragma unroll
            for (int m = 0; m < 4; ++m)
#pragma unroll
                for (int n = 0; n < 2; ++n) acc[a][b][m][n] = (f32x4){0.f, 0.f, 0.f, 0.f};
    bf16x8 At[4][2], B0[2][2], B1[2][2];
    const char* cA = (const char*)(cur.sel ? g.A1 : g.A0) + (size_t)cur.pm * tstepA; const char* cB = (const char*)(cur.sel ? g.B1 : g.B0) + (size_t)cur.pn * tstepB;
    PG8_STAGE(PG8_SB(0, 0), cB, voffB); PG8_STAGE(PG8_SB(0, 1), cB + hstepB, voffB); PG8_STAGE(PG8_SA(0, 0), cA, voffA); PG8_STAGE(PG8_SA(0, 1), cA + hstepA, voffA);
    if (wr == 1) PG8_BAR;
    PG8_WAIT_V(2); PG8_BAR;
    PG8_STAGE(PG8_SB(1, 0), cB + kstep, voffB); PG8_STAGE(PG8_SA(1, 0), cA + kstep, voffA); PG8_STAGE(PG8_SB(1, 1), cB + hstepB + kstep, voffB);
    PG8_WAIT_V(6); PG8_BAR;
    for (;;) {
        if (ui > 0) PG8_LANE_CONSTS();
        const int cun = S.next(ui + 1); const bool has_next = cun >= 0;
        if (has_next) nxt = unit_decode(cun);
        const char* nA = has_next ? (const char*)(nxt.sel ? g.A1 : g.A0) + (size_t)nxt.pm * tstepA : cA; const char* nB = has_next ? (const char*)(nxt.sel ? g.B1 : g.B0) + (size_t)nxt.pn * tstepB : cB;
        for (int t = 0; t < nt; t += 2) {
            const bool last = (t == nt - 2);
            const char* a1 = cA + (size_t)(t + 1) * kstep;
            const char* a2 = last ? nA : cA + (size_t)(t + 2) * kstep; const char* b2 = last ? nB : cB + (size_t)(t + 2) * kstep;
            const char* a3 = a2 + kstep; const char* b3 = b2 + kstep;
            PG8_LDB(B0, 0, 0); PG8_LDB(B1, 0, 1); PG8_SCHED; PG8_LDA(At, 0, 0); PG8_STAGE(PG8_SA(1, 1), a1 + hstepA, voffA);
            PG8_WAIT_V(8); PG8_WAIT_L(0); PG8_BAR; PG8_MMA(0, 0, At, B0); PG8_MMA(0, 1, At, B1); PG8_BAR; PG8_SCHED;
            PG8_LDA(At, 0, 1); PG8_STAGE(PG8_SB(0, 0), b2, voffB); PG8_STAGE(PG8_SB(0, 1), b2 + hstepB, voffB); PG8_STAGE(PG8_SA(0, 0), a2, voffA);
            PG8_WAIT_V(8); PG8_WAIT_L(0); PG8_BAR; PG8_MMA(1, 0, At, B0); PG8_MMA(1, 1, At, B1); PG8_BAR; PG8_SCHED;
            PG8_LDB(B0, 1, 0); PG8_LDB(B1, 1, 1); PG8_SCHED; PG8_LDA(At, 1, 0); PG8_STAGE(PG8_SA(0, 1), a2 + hstepA, voffA);
            PG8_WAIT_V(8); PG8_WAIT_L(0); PG8_BAR; PG8_MMA(0, 0, At, B0); PG8_MMA(0, 1, At, B1); PG8_BAR; PG8_SCHED;
            PG8_LDA(At, 1, 1); PG8_STAGE(PG8_SB(1, 0), b3, voffB); PG8_STAGE(PG8_SB(1, 1), b3 + hstepB, voffB); PG8_STAGE(PG8_SA(1, 0), a3, voffA);
            PG8_WAIT_V(8); PG8_WAIT_L(0); PG8_BAR; PG8_MMA(1, 0, At, B0); PG8_MMA(1, 1, At, B1); PG8_BAR; PG8_SCHED;
        }
        if constexpr (ALIGN_EPI) { if (wr == 0) PG8_BAR; }
        { const int le_ = opaque(tid) & 63; E(acc, cur, wr, wc, le_ & 15, le_ >> 4); }
        if (!has_next) break;
#pragma unroll
        for (int a = 0; a < 2; ++a)
#pragma unroll
            for (int b = 0; b < 2; ++b)
#pragma unroll
                for (int m = 0; m < 4; ++m)
#pragma unroll
                    for (int n = 0; n < 2; ++n) acc[a][b][m][n] = (f32x4){0.f, 0.f, 0.f, 0.f};
        cur = nxt; cA = nA; cB = nB; ++ui;
        if constexpr (ALIGN_EPI) { if (wr == 1) PG8_BAR; }
    }
    PG8_WAIT_V(0);
    if constexpr (!ALIGN_EPI) { if (wr == 0) PG8_BAR; }
    PG8_BAR;
#undef PG8_LANE_CONSTS
#undef PG8_SA
#undef PG8_SB
#undef PG8_STAGE
#undef PG8_LDA
#undef PG8_LDB
#undef PG8_MMA
#undef PG8_WAIT_V
#undef PG8_WAIT_L
#undef PG8_BAR
#undef PG8_SCHED
}
}

#define XB_TMO      128
#define XB_XCNT(j)  (256  + 64 * (j))
#define XB_XSUB(j)  (1280 + 64 * (j))
#define XB_XGEN(j)  (2304 + 64 * (j))
#define XB_TOP      3328
#define XB_TOPGEN   3392
#define XCD_BAR_WORDS 3456
#define XB_SPIN_CAP (1u << 20)
DI unsigned xb_ld(unsigned* p)              { return __hip_atomic_load(p, __ATOMIC_RELAXED, __HIP_MEMORY_SCOPE_AGENT); }
DI unsigned xb_add(unsigned* p, unsigned v) { return __hip_atomic_fetch_add(p, v, __ATOMIC_RELAXED, __HIP_MEMORY_SCOPE_AGENT); }
DI unsigned xb_xcc_id() { return (unsigned)__builtin_amdgcn_s_getreg((3 << 11) | 20) & 0xFu; }
#define XB_SPIN(cond, bar) do { unsigned _sp = 0; while (cond) { __builtin_amdgcn_s_sleep(1); \
    if ((++_sp & 255u) == 0u) { if (xb_ld(&(bar)[XB_TMO])) break; if (_sp > XB_SPIN_CAP) { atomicAdd(&(bar)[XB_TMO], 1u); break; } } } } while (0)
struct XcdBarrier { unsigned* bar; unsigned x; volatile LAS unsigned* st; };
DI XcdBarrier xcd_barrier_post(unsigned* bar, volatile LAS unsigned* st) {
    XcdBarrier b; b.bar = bar; b.x = xb_xcc_id(); b.st = st;
    if (threadIdx.x == 0) (void)xb_add(&bar[XB_XCNT(b.x)], 1u);
    return b;
}
DI void xcd_barrier_complete(unsigned* bar, unsigned x, unsigned& nloc, unsigned& nx) {
    const unsigned G = gridDim.x * gridDim.y * gridDim.z;
    unsigned sum, cnt, mine, sp = 0u;
    for (;;) {
        sum = 0u; cnt = 0u; mine = 0u;
#pragma unroll
        for (unsigned j = 0; j < 16; ++j) { const unsigned c = xb_ld(&bar[XB_XCNT(j)]); sum += c; cnt += (c > 0u) ? 1u : 0u; mine = (j == x) ? c : mine; }
        if (sum == G) break;
        __builtin_amdgcn_s_sleep(1);
        if ((++sp & 255u) == 0u) { if (xb_ld(&bar[XB_TMO])) break; if (sp > XB_SPIN_CAP) { atomicAdd(&bar[XB_TMO], 1u); break; } }
    }
    nloc = mine > 0u ? mine : 1u; nx = cnt > 0u ? cnt : 1u;
}
DI void xcd_barrier(const XcdBarrier& b) {
    asm volatile("s_waitcnt vmcnt(0)" ::: "memory");
    __syncthreads();
    if (threadIdx.x == 0) {
        unsigned* bar = b.bar;
        __builtin_amdgcn_s_waitcnt(0);
        unsigned nloc = b.st[0], nx = b.st[1];
        if (nloc == 0u) { xcd_barrier_complete(bar, b.x, nloc, nx); b.st[0] = nloc; b.st[1] = nx; }
        const unsigned old = xb_add(&bar[XB_XSUB(b.x)], 1u);
        const unsigned gen = old / nloc;
        if (old + 1u == (gen + 1u) * nloc) {
            __builtin_amdgcn_fence(__ATOMIC_RELEASE, "agent");
            asm volatile("s_waitcnt vmcnt(0)" ::: "memory");
            const unsigned og = xb_add(&bar[XB_TOP], 1u);
            const unsigned tg = og / nx;
            if (og + 1u == (tg + 1u) * nx) xb_add(&bar[XB_TOPGEN], 1u);
            else XB_SPIN(xb_ld(&bar[XB_TOPGEN]) == tg, bar);
            __builtin_amdgcn_fence(__ATOMIC_ACQUIRE, "agent");
            xb_add(&bar[XB_XGEN(b.x)], 1u);
            asm volatile("s_waitcnt vmcnt(0)" ::: "memory");
        } else {
            XB_SPIN(xb_ld(&bar[XB_XGEN(b.x)]) == gen, bar);
            __builtin_amdgcn_fence(__ATOMIC_ACQUIRE, "agent");
            asm volatile("s_waitcnt vmcnt(0)" ::: "memory");
        }
    }
    __syncthreads();
}

struct Args { const float* in[22]; float* out; unsigned char* ws; };
enum { I_X = 0, I_C, I_CTX, I_CCTX, I_WADA, I_BADA, I_N1G, I_WIN, I_LNVG, I_LNVB, I_WS, I_BS, I_WDEC2, I_BDEC, I_ONG, I_PA, I_PB, I_WOUT, I_N2G, I_WFF1, I_WFF2, I_FING };

DI void p0_transpose_item(const float* W, int pitch, int K, int nblk, bf16_t* WT, int row_off, LAS float* scr, int item, int lane) {
    const int kb = item / nblk, nb = item % nblk, k0 = 64 * kb, n0 = 32 * nb;
    {
        const int c4 = (lane & 7) * 4; f32x4 v[8];
#pragma unroll
        for (int i = 0; i < 8; ++i) v[i] = *(const f32x4*)(W + (size_t)(k0 + 8 * i + (lane >> 3)) * pitch + n0 + c4);
#pragma unroll
        for (int i = 0; i < 8; ++i) { LAS float* d = scr + (8 * i + (lane >> 3)) * 33 + c4; d[0] = v[i].x; d[1] = v[i].y; d[2] = v[i].z; d[3] = v[i].w; }
    }
    LDS_WAIT(); asm volatile("" ::: "memory");
    const int c = lane & 7;
#pragma unroll
    for (int j = 0; j < 4; ++j) { const int n = (lane >> 3) + 8 * j; const LAS float* s = scr + (8 * c) * 33 + n;
        u32x4 o; o.x = pk2(s[0 * 33], s[1 * 33]); o.y = pk2(s[2 * 33], s[3 * 33]); o.z = pk2(s[4 * 33], s[5 * 33]); o.w = pk2(s[6 * 33], s[7 * 33]);
        *(u32x4*)(WT + (size_t)(row_off + n0 + n) * K + k0 + 8 * c) = o; }
    LDS_WAIT(); asm volatile("" ::: "memory");
}
DI void p0_prologue(const Args& a, LAS unsigned char* lds, int vcu, int G, int wave, int lane) {
    unsigned char* ws = a.ws;
    LAS float* scr = (LAS float*)(lds + wave * 16384);
    const int gw = vcu * NWAVES + wave, NGW = G * NWAVES;
    constexpr int I_IN1 = 16 * 160, I_IN2 = 16 * 64, I_IN3 = 16, I_SQ = 16 * 32, I_F1 = 16 * 128, I_F2 = 64 * 32;
    constexpr int NITEMS = I_IN1 + I_IN2 + I_IN3 + 3 * I_SQ + I_F1 + I_F2;
    for (int it = gw; it < NITEMS; it += NGW) {
        int r = it;
        if (r < I_IN1) { p0_transpose_item(a.in[I_WIN], WIN_PITCH, DM, 160, (bf16_t*)(ws + WS_WIN), 0, scr, r, lane); continue; } r -= I_IN1;
        if (r < I_IN2) { p0_transpose_item(a.in[I_WIN] + 5152, WIN_PITCH, DM, 64, (bf16_t*)(ws + WS_WIN), 5120, scr, r, lane); continue; } r -= I_IN2;
        if (r < I_IN3) { p0_transpose_item(a.in[I_WIN] + 5120, WIN_PITCH, DM, 1, (bf16_t*)(ws + WS_WIN), 7168, scr, r, lane); continue; } r -= I_IN3;
        if (r < I_SQ) { p0_transpose_item(a.in[I_PA], DM, DM, 32, (bf16_t*)(ws + WS_PA), 0, scr, r, lane); continue; } r -= I_SQ;
        if (r < I_SQ) { p0_transpose_item(a.in[I_PB], DM, DM, 32, (bf16_t*)(ws + WS_PB), 0, scr, r, lane); continue; } r -= I_SQ;
        if (r < I_SQ) { p0_transpose_item(a.in[I_WOUT], DM, DM, 32, (bf16_t*)(ws + WS_WO), 0, scr, r, lane); continue; } r -= I_SQ;
        if (r < I_F1) { p0_transpose_item(a.in[I_WFF1], DFF, DM, 128, (bf16_t*)(ws + WS_W1), 0, scr, r, lane); continue; } r -= I_F1;
        p0_transpose_item(a.in[I_WFF2], DM, DFF, 32, (bf16_t*)(ws + WS_W2), 0, scr, r, lane);
    }
    {
        u32x4* z = (u32x4*)((bf16_t*)(ws + WS_WIN) + (size_t)7200 * DM);
        for (int e = gw * 64 + lane; e < 224 * DM / 8; e += NGW * 64) z[e] = (u32x4){0u, 0u, 0u, 0u};
    }
    {
        const float* wada = a.in[I_WADA]; const float* cc = a.in[I_C]; const float* cx = a.in[I_CCTX];
        float* modp = (float*)(ws + WS_MODP);
        LAS float* sl = (LAS float*)(lds + SILU_OFF);
        if (NGW - 1 - gw < 8 * 24) {
            for (int k = lane; k < 128 * 3; k += 64) { const int ks = (NGW - 1 - gw) / 24; const int v = k >> 7, kk = ks * 128 + (k & 127);
                const float c0 = v == 0 ? cc[kk] : (v == 1 ? cc[DM + kk] : cx[kk]); sl[wave * 384 + k] = c0 * sigm(c0); }
            LDS_WAIT(); asm volatile("" ::: "memory");
        }
        for (int it = (NGW - 1 - gw); it < 8 * 24; it += NGW) {
            const int ks = it / 24, cb = it % 24, col = cb * 256 + lane * 4;
            f32x4 a0 = {0.f, 0.f, 0.f, 0.f}, a1 = a0, a2 = a0;
#pragma unroll 8
            for (int k = 0; k < 128; ++k) {
                const f32x4 w = *(const f32x4*)(wada + (size_t)(ks * 128 + k) * 6144 + col);
                a0 += w * sl[wave * 384 + k]; a1 += w * sl[wave * 384 + 128 + k]; a2 += w * sl[wave * 384 + 256 + k];
            }
            *(f32x4*)(modp + (ks * 3 + 0) * 6144 + col) = a0; *(f32x4*)(modp + (ks * 3 + 1) * 6144 + col) = a1; *(f32x4*)(modp + (ks * 3 + 2) * 6144 + col) = a2;
        }
    }
    {
        float* pos = (float*)(ws + WS_POS);
        const int gt = gw * 64 + lane, NT = NGW * 64;
        for (int e = gt; e < 192 * 512; e += NT) {
            const int p = e >> 9, ch = e & 511;
            const int prow = p < 128 ? p : p - 128;
            const int fi = ch & 255;
            const float pw = (float)pow(10000.0, (double)((float)fi * (1.0f / 256.0f)));
            const float fr = 1.0f / pw;
            const float ang = (float)prow * fr;
            const double dv = (ch < 256) ? sin((double)ang) : cos((double)ang);
            pos[e] = (float)dv;
        }
    }
}

DI void p1_rows(const Args& a, LAS unsigned char* lds, int vcu, int G, int wave, int lane, int tid) {
    unsigned char* ws = a.ws;
    const float* modp = (const float*)(ws + WS_MODP); const float* bada = a.in[I_BADA];
    LAS float* modl = (LAS float*)lds;
    for (int idx = tid; idx < 3 * 2048; idx += NTHR) {
        const int v = idx >> 11, col = idx & 2047;
        float s = bada[col];
#pragma unroll
        for (int ks = 0; ks < 8; ++ks) s += modp[(ks * 3 + v) * 6144 + col];
        modl[idx] = s;
    }
    if (blockIdx.x < 36) {
        const int idx = blockIdx.x * NTHR + tid; const int v = idx / 6144, col = idx % 6144;
        float s = bada[col];
#pragma unroll
        for (int ks = 0; ks < 8; ++ks) s += modp[(ks * 3 + v) * 6144 + col];
        ((float*)(ws + WS_MODF))[idx] = s;
    }
    __syncthreads();
    const float* pos = (const float*)(ws + WS_POS);
    const float* g1 = a.in[I_N1G];
    bf16_t* H = (bf16_t*)(ws + WS_H);
    const int gw = vcu * NWAVES + wave, NGW = G * NWAVES;
    for (int m = gw; m < MT; m += NGW) {
        const float* xr; int v; const float* pr = nullptr; const float* pc = nullptr;
        if (m < M) { xr = a.in[I_X] + (size_t)m * DM; v = m >> 13; const int t = m & (SEQ - 1); pr = pos + (size_t)(t >> 6) * 512; pc = pos + (size_t)(128 + (t & 63)) * 512; }
        else { xr = a.in[I_CTX] + (size_t)(m - M) * DM; v = 2; }
        f32x4 x[4]; float ss = 0.f;
#pragma unroll
        for (int j = 0; j < 4; ++j) {
            x[j] = *(const f32x4*)(xr + 256 * j + 4 * lane);
            if (m < M) { const float* pp = (j < 2 ? pr + 256 * j : pc + 256 * (j - 2)) + 4 * lane; x[j] += *(const f32x4*)pp; }
            ss += (x[j].x * x[j].x + x[j].y * x[j].y) + (x[j].z * x[j].z + x[j].w * x[j].w);
        }
        const float rs = rsqrtf(wave_sum(ss) * (1.f / DM) + EPS);
        unsigned long long* o8 = (unsigned long long*)(H + (size_t)m * DM) + lane;
#pragma unroll
        for (int j = 0; j < 4; ++j) {
            const int ch = 256 * j + 4 * lane;
            const f32x4 g = *(const f32x4*)(g1 + ch);
            const f32x4 sh = *(const LAS f32x4*)(modl + v * 2048 + ch), sc = *(const LAS f32x4*)(modl + v * 2048 + 1024 + ch);
            const f32x4 h = x[j] * rs * g * (sc + 1.f) + sh;
            o8[64 * j] = (unsigned long long)pk2(h.x, h.y) | ((unsigned long long)pk2(h.z, h.w) << 32);
        }
    }
}
DI void p5c_rows(const Args& a, int vcu, int G, int wave, int lane) {
    unsigned char* ws = a.ws;
    const float* modf = (const float*)(ws + WS_MODF); const float* g2 = a.in[I_N2G];
    bf16_t* H = (bf16_t*)(ws + WS_H);
    const int gw = vcu * NWAVES + wave, NGW = G * NWAVES;
    for (int m = gw; m < M; m += NGW) {
        const float* xr = a.out + (size_t)m * DM; const int v = m >> 13;
        f32x4 x[4]; float ss = 0.f;
#pragma unroll
        for (int j = 0; j < 4; ++j) { x[j] = *(const f32x4*)(xr + 256 * j + 4 * lane); ss += (x[j].x * x[j].x + x[j].y * x[j].y) + (x[j].z * x[j].z + x[j].w * x[j].w); }
        const float rs = rsqrtf(wave_sum(ss) * (1.f / DM) + EPS);
        unsigned long long* o8 = (unsigned long long*)(H + (size_t)m * DM) + lane;
#pragma unroll
        for (int j = 0; j < 4; ++j) {
            const int ch = 256 * j + 4 * lane;
            const f32x4 g = *(const f32x4*)(g2 + ch);
            const f32x4 sh = *(const f32x4*)(modf + v * 6144 + 3 * 1024 + ch), sc = *(const f32x4*)(modf + v * 6144 + 4 * 1024 + ch);
            const f32x4 h = x[j] * rs * g * (sc + 1.f) + sh;
            o8[64 * j] = (unsigned long long)pk2(h.x, h.y) | ((unsigned long long)pk2(h.z, h.w) << 32);
        }
    }
}
DI void p7_rows(const Args& a, int vcu, int G, int wave, int lane) {
    const float* fg = a.in[I_FING];
    const int gw = vcu * NWAVES + wave, NGW = G * NWAVES;
    for (int m = gw; m < M; m += NGW) {
        float* xr = a.out + (size_t)m * DM;
        f32x4 x[4]; float ss = 0.f;
#pragma unroll
        for (int j = 0; j < 4; ++j) { x[j] = *(const f32x4*)(xr + 256 * j + 4 * lane); ss += (x[j].x * x[j].x + x[j].y * x[j].y) + (x[j].z * x[j].z + x[j].w * x[j].w); }
        const float rs = rsqrtf(wave_sum(ss) * (1.f / DM) + EPS);
#pragma unroll
        for (int j = 0; j < 4; ++j) { const int ch = 256 * j + 4 * lane; const f32x4 g = *(const f32x4*)(fg + ch); *(f32x4*)(xr + ch) = x[j] * rs * g; }
    }
}

template <int ACT> DI float actf(float x, float scale) {
    if (ACT == 0) return x * scale;
    if (ACT == 1) return x * sigm(x * (1.5957691216057308f + 0.07135481627362205f * x * x));
    if (ACT == 2) return x * sigm(x);
    if (ACT == 3) return sigm(x);
    return x;
}
struct EpiZ {
    static constexpr bool PERM = true;
    unsigned char* ws; bf16_t* gates;
    template <int ACT, bool STATS> DI void run(const f32x4 (&acc)[2][2][4][2], bf16_t* base, int ldc, int row0, int col0, float scale, float* stat, int slot, int fq) const {
#pragma unroll
        for (int ai = 0; ai < 2; ++ai)
#pragma unroll
            for (int m = 0; m < 4; ++m) {
                const int row = row0 + ai * 128 + m * 16; bf16_t* rowp = base + (size_t)row * ldc + col0;
                float s = 0.f, q = 0.f;
#pragma unroll
                for (int bj = 0; bj < 2; ++bj) {
                    float v[8];
#pragma unroll
                    for (int e = 0; e < 4; ++e) { v[e] = actf<ACT>(acc[ai][bj][m][0][e], scale); v[4 + e] = actf<ACT>(acc[ai][bj][m][1][e], scale); }
                    if (STATS) {
#pragma unroll
                        for (int e = 0; e < 8; ++e) { s += v[e]; q += v[e] * v[e]; } }
                    u32x4 w; w.x = pk2(v[0], v[1]); w.y = pk2(v[2], v[3]); w.z = pk2(v[4], v[5]); w.w = pk2(v[6], v[7]);
                    *(u32x4*)(rowp + bj * 128) = w;
                    __builtin_amdgcn_sched_barrier(0);
                }
                if (STATS) {
                    s += __shfl_xor(s, 16); s += __shfl_xor(s, 32); q += __shfl_xor(q, 16); q += __shfl_xor(q, 32);
                    if (fq == 0) *(f32x2*)(stat + ((size_t)row * 16 + slot) * 2) = (f32x2){s, q};
                }
                __builtin_amdgcn_sched_barrier(0);
            }
    }
    DI void operator()(const f32x4 (&acc)[2][2][4][2], const pg8::Unit& u, int wr, int wc, int fr, int fq) const {
        const int pn = u.pn, row0 = u.pm * 256 + wr * 64 + fr, cw = wc * 32 + 8 * fq;
        if (pn == 28) {
            if (wc == 0) {
                float* dec = (float*)(ws + WS_DEC) + (size_t)(u.sel ? M : 0) * 32;
#pragma unroll
                for (int ai = 0; ai < 2; ++ai)
#pragma unroll
                    for (int m = 0; m < 4; ++m) { float* dp = dec + (size_t)(row0 + ai * 128 + m * 16) * 32 + 8 * fq; *(f32x4*)dp = acc[ai][0][m][0]; *(f32x4*)(dp + 4) = acc[ai][0][m][1]; }
            }
            return;
        }
        if (u.sel == 1) {
            if (pn < 12) run<0, false>(acc, (bf16_t*)(ws + WS_KC), 512, row0, (pn - 10) * 256 + cw, 1.f, nullptr, 0, fq);
            else run<0, false>(acc, (bf16_t*)(ws + WS_VC), 1024, row0, (pn - 12) * 256 + cw, 1.f, nullptr, 0, fq);
            return;
        }
        if (pn < 4) run<1, false>(acc, (bf16_t*)(ws + WS_GU), 1024, row0, pn * 256 + cw, 1.f, nullptr, 0, fq);
        else if (pn < 8) run<1, true>(acc, (bf16_t*)(ws + WS_GV), 1024, row0, (pn - 4) * 256 + cw, 1.f, (float*)(ws + WS_STAT), (pn - 4) * 4 + wc, fq);
        else if (pn < 10) run<0, false>(acc, (bf16_t*)(ws + WS_Q), 512, row0, (pn - 8) * 256 + cw, 0.08838834764831845f, nullptr, 0, fq);
        else if (pn < 12) run<0, false>(acc, (bf16_t*)(ws + WS_K), 512, row0, (pn - 10) * 256 + cw, 1.f, nullptr, 0, fq);
        else if (pn < 16) run<0, false>(acc, (bf16_t*)(ws + WS_V), 1024, row0, (pn - 12) * 256 + cw, 1.f, nullptr, 0, fq);
        else if (pn < 20) run<2, false>(acc, (bf16_t*)(ws + WS_R), 1024, row0, (pn - 16) * 256 + cw, 1.f, nullptr, 0, fq);
        else run<3, false>(acc, gates, 2048, row0, (pn - 20) * 256 + cw, 1.f, nullptr, 0, fq);
    }
};
struct SchedP2 {
    int G, c;
    DI int next(int i) const {
        int L = i * G + c;
        if (L < 64 * 28) { int pm, pn; pg8::tile_order(L, 64, 28, pm, pn); return pm | (pn << 8); }
        L -= 64 * 28;
        if (L < 64) return L | (28 << 8);
        L -= 64;
        if (L < 2) return L | (28 << 8) | (1 << 16);
        L -= 2;
        if (L < 12) return (L / 6) | ((10 + (L % 6)) << 8) | (1 << 16);
        return -1;
    }
};
struct EpiMerge {
    static constexpr bool PERM = true;
    bf16_t* MG; const bf16_t* gates;
    DI void operator()(const f32x4 (&acc)[2][2][4][2], const pg8::Unit& u, int wr, int wc, int fr, int fq) const {
        const int row0 = u.pm * 256 + wr * 64 + fr, col0 = u.pn * 256 + wc * 32 + 8 * fq;
#pragma unroll
        for (int ai = 0; ai < 2; ++ai)
#pragma unroll
            for (int m = 0; m < 4; ++m) {
                const int row = row0 + ai * 128 + m * 16;
#pragma unroll
                for (int bj = 0; bj < 2; ++bj) {
                    const int col = col0 + bj * 128;
                    const u32x4 gw = *(const u32x4*)(gates + (size_t)row * 2048 + u.sel * 1024 + col);
                    bf16_t* mp = MG + (size_t)row * DM + col;
                    float v[8];
                    v[0] = bflo(gw.x) * acc[ai][bj][m][0][0]; v[1] = bfhi(gw.x) * acc[ai][bj][m][0][1]; v[2] = bflo(gw.y) * acc[ai][bj][m][0][2]; v[3] = bfhi(gw.y) * acc[ai][bj][m][0][3];
                    v[4] = bflo(gw.z) * acc[ai][bj][m][1][0]; v[5] = bfhi(gw.z) * acc[ai][bj][m][1][1]; v[6] = bflo(gw.w) * acc[ai][bj][m][1][2]; v[7] = bfhi(gw.w) * acc[ai][bj][m][1][3];
                    if (u.sel == 1) {
                        const u32x4 pv = *(const u32x4*)mp;
                        v[0] += bflo(pv.x); v[1] += bfhi(pv.x); v[2] += bflo(pv.y); v[3] += bfhi(pv.y); v[4] += bflo(pv.z); v[5] += bfhi(pv.z); v[6] += bflo(pv.w); v[7] += bfhi(pv.w);
                    }
                    u32x4 w; w.x = pk2(v[0], v[1]); w.y = pk2(v[2], v[3]); w.z = pk2(v[4], v[5]); w.w = pk2(v[6], v[7]);
                    *(u32x4*)mp = w;
                }
            }
    }
};
struct SchedMerge {
    int G, c;
    DI int next(int i) const {
        const int tile = (i >> 1) * G + c; if (tile >= 256) return -1;
        int pm, pn; pg8::tile_order(tile, 64, 4, pm, pn); return pm | (pn << 8) | ((i & 1) << 16);
    }
};
struct EpiRes1 {
    static constexpr bool PERM = false;
    const float* x; const float* pos; const float* modf; float* out;
    DI void operator()(const f32x4 (&acc)[2][2][4][2], const pg8::Unit& u, int wr, int wc, int fr, int fq) const {
        const int row0 = u.pm * 256 + wr * 64 + fr, col0 = u.pn * 256 + wc * 32 + 4 * fq;
        const float* g1 = modf + (u.pm >> 5) * 6144 + 2 * 1024;
#pragma unroll
        for (int ai = 0; ai < 2; ++ai)
#pragma unroll
            for (int m = 0; m < 4; ++m) {
                const int row = row0 + ai * 128 + m * 16, t = row & (SEQ - 1);
#pragma unroll
                for (int bj = 0; bj < 2; ++bj)
#pragma unroll
                    for (int n = 0; n < 2; ++n) {
                        const int col = col0 + bj * 128 + n * 16;
                        const float* pp = (col < 512) ? pos + (size_t)(t >> 6) * 512 + col : pos + (size_t)(128 + (t & 63)) * 512 + (col - 512);
                        const f32x4 xv = *(const f32x4*)(x + (size_t)row * DM + col), pv = *(const f32x4*)pp, gv = *(const f32x4*)(g1 + col);
                        *(f32x4*)(out + (size_t)row * DM + col) = xv + pv + gv * acc[ai][bj][m][n];
                    }
            }
    }
};
struct EpiFF1 {
    static constexpr bool PERM = true;
    bf16_t* T;
    DI void operator()(const f32x4 (&acc)[2][2][4][2], const pg8::Unit& u, int wr, int wc, int fr, int fq) const {
        const int row0 = u.pm * 256 + wr * 64 + fr, col0 = u.pn * 256 + wc * 32 + 8 * fq;
#pragma unroll
        for (int ai = 0; ai < 2; ++ai)
#pragma unroll
            for (int m = 0; m < 4; ++m) {
                bf16_t* rowp = T + (size_t)(row0 + ai * 128 + m * 16) * DFF + col0;
#pragma unroll
                for (int bj = 0; bj < 2; ++bj) {
                    float v[8];
#pragma unroll
                    for (int e = 0; e < 4; ++e) { const float a0 = fmaxf(acc[ai][bj][m][0][e], 0.f), a1 = fmaxf(acc[ai][bj][m][1][e], 0.f); v[e] = a0 * a0; v[4 + e] = a1 * a1; }
                    u32x4 w; w.x = pk2(v[0], v[1]); w.y = pk2(v[2], v[3]); w.z = pk2(v[4], v[5]); w.w = pk2(v[6], v[7]);
                    *(u32x4*)(rowp + bj * 128) = w;
                }
            }
    }
};
struct EpiRes2 {
    static constexpr bool PERM = false;
    const float* modf; float* out;
    DI void operator()(const f32x4 (&acc)[2][2][4][2], const pg8::Unit& u, int wr, int wc, int fr, int fq) const {
        const int row0 = u.pm * 256 + wr * 64 + fr, col0 = u.pn * 256 + wc * 32 + 4 * fq;
        const float* g2 = modf + (u.pm >> 5) * 6144 + 5 * 1024;
#pragma unroll
        for (int ai = 0; ai < 2; ++ai)
#pragma unroll
            for (int m = 0; m < 4; ++m) {
                const int row = row0 + ai * 128 + m * 16;
#pragma unroll
                for (int bj = 0; bj < 2; ++bj)
#pragma unroll
                    for (int n = 0; n < 2; ++n) {
                        const int col = col0 + bj * 128 + n * 16;
                        float* op = out + (size_t)row * DM + col;
                        const f32x4 xv = *(const f32x4*)op, gv = *(const f32x4*)(g2 + col);
                        *(f32x4*)op = xv + gv * acc[ai][bj][m][n];
                    }
            }
    }
};

DI int crow(int reg, int h) { return (reg & 3) + 8 * (reg >> 2) + 4 * h; }
DI void mma32(f32x16& acc, const LAS unsigned char* A, int pitchA, const LAS unsigned char* B, int pitchB, int K, int lane) {
    const int r = lane & 31, h = lane >> 5;
    const LAS unsigned char* pa = A + r * pitchA + h * 16;
    const LAS unsigned char* pb = B + r * pitchB + h * 16;
#pragma unroll 4
    for (int k = 0; k < K; k += 16) {
        const bf16x8 av = *(const LAS bf16x8*)(pa + k * 2);
        const bf16x8 bv = *(const LAS bf16x8*)(pb + k * 2);
        acc = __builtin_amdgcn_mfma_f32_32x32x16_bf16(av, bv, acc, 0, 0, 0);
    }
}

DI bf16x8 tr_frag(const LAS unsigned char* T, int pitch, int k0, int c0, int lane) {
    const int h = lane >> 5, blk = (lane >> 4) & 1, q = (lane & 15) >> 2, p = lane & 3;
    const LAS unsigned char* a = T + (k0 + 8 * h + q) * pitch + (c0 + 16 * blk + 4 * p) * 2;
    const s16x4 lo = __builtin_amdgcn_ds_read_tr16_b64_v4i16((LAS s16x4*)a);
    const s16x4 hi = __builtin_amdgcn_ds_read_tr16_b64_v4i16((LAS s16x4*)(a + 4 * pitch));
    return __builtin_shufflevector(lo, hi, 0, 1, 2, 3, 4, 5, 6, 7);
}

constexpr int CM_PW = 272, CM_PV = 576, CM_PS = 528;
constexpr int CM_W = 0, CM_VN = 128 * CM_PW, CM_MU = CM_VN + 128 * CM_PV, CM_SO = CM_VN;
static_assert(CM_MU + 1024 <= RING_BYTES && 128 * CM_PS <= 128 * CM_PV, "chunk-MLP LDS map");
DI void p3a_chunk_mlp(const Args& a, LAS unsigned char* lds, int vcu, int G, int wave, int lane, int tid) {
    unsigned char* ws = a.ws;
    const bf16_t* GV = (const bf16_t*)(ws + WS_GV); bf16_t* GU = (bf16_t*)(ws + WS_GU);
    const float* stat = (const float*)(ws + WS_STAT);
    const float* lng = a.in[I_LNVG]; const float* lnb = a.in[I_LNVB]; const float* wsp = a.in[I_WS]; const float* bsp = a.in[I_BS];
    const int r = lane & 31, h = lane >> 5;
    for (int item = vcu; item < 512; item += G) {
        const int chunk = item >> 2, g = item & 3, row_base = chunk * 128;
        if (tid < 128) {
            const float* sp = stat + (size_t)(row_base + tid) * 32; float s = 0.f, q = 0.f;
#pragma unroll
            for (int k = 0; k < 8; ++k) { const f32x4 v = *(const f32x4*)(sp + 4 * k); s += v.x + v.z; q += v.y + v.w; }
            const float mu = s * (1.f / 1024.f); const float var = fmaxf(q * (1.f / 1024.f) - mu * mu, 0.f);
            *(LAS f32x2*)(lds + CM_MU + tid * 8) = (f32x2){mu, rsqrtf(var + EPS)};
        }
#pragma unroll
        for (int i = 0; i < 8; ++i) {
            const int e = (i * NTHR + tid) * 4, p = e >> 7, q = e & 127;
            const f32x4 w = *(const f32x4*)(wsp + (size_t)g * 16384 + e);
            *(LAS u32x2*)(lds + CM_W + p * CM_PW + q * 2) = (u32x2){pk2(w.x, w.y), pk2(w.z, w.w)};
        }
        __syncthreads();
        {
            const int c16 = tid & 31, ch = g * 256 + c16 * 8;
            const f32x4 g0 = *(const f32x4*)(lng + ch), g1 = *(const f32x4*)(lng + ch + 4), b0 = *(const f32x4*)(lnb + ch), b1 = *(const f32x4*)(lnb + ch + 4);
#pragma unroll
            for (int i = 0; i < 8; ++i) {
                const int q = i * 16 + (tid >> 5);
                const u32x4 gv = *(const u32x4*)(GV + (size_t)(row_base + q) * DM + ch);
                const f32x2 ms = *(const LAS f32x2*)(lds + CM_MU + q * 8);
                u32x4 w;
                w.x = pk2((bflo(gv.x) - ms.x) * ms.y * g0.x + b0.x, (bfhi(gv.x) - ms.x) * ms.y * g0.y + b0.y);
                w.y = pk2((bflo(gv.y) - ms.x) * ms.y * g0.z + b0.z, (bfhi(gv.y) - ms.x) * ms.y * g0.w + b0.w);
                w.z = pk2((bflo(gv.z) - ms.x) * ms.y * g1.x + b1.x, (bfhi(gv.z) - ms.x) * ms.y * g1.y + b1.y);
                w.w = pk2((bflo(gv.w) - ms.x) * ms.y * g1.z + b1.z, (bfhi(gv.w) - ms.x) * ms.y * g1.w + b1.w);
                *(LAS u32x4*)(lds + CM_VN + q * CM_PV + c16 * 16) = w;
            }
        }
        __syncthreads();
        f32x16 acc[4];
#pragma unroll
        for (int ti = 0; ti < 4; ++ti) for (int e = 0; e < 16; ++e) acc[ti][e] = 0.f;
#pragma unroll
        for (int ks = 0; ks < 8; ++ks) {
            const bf16x8 bv = tr_frag(lds + CM_VN, CM_PV, 16 * ks, wave * 32, lane);
#pragma unroll
            for (int ti = 0; ti < 4; ++ti) {
                const bf16x8 av = *(const LAS bf16x8*)(lds + CM_W + (ti * 32 + r) * CM_PW + (16 * ks + 8 * h) * 2);
                acc[ti] = __builtin_amdgcn_mfma_f32_32x32x16_bf16(av, bv, acc[ti], 0, 0, 0);
            }
        }
        __syncthreads();
        {
            const int c = wave * 32 + r;
#pragma unroll
            for (int ti = 0; ti < 4; ++ti)
#pragma unroll
                for (int e = 0; e < 16; ++e) { const int p = ti * 32 + crow(e, h); *(LAS bf16_t*)(lds + CM_SO + p * CM_PS + c * 2) = f2bf(acc[ti][e] + bsp[g * 128 + p]); }
        }
        __syncthreads();
        {
            const int c16 = tid & 31, ch = g * 256 + c16 * 8;
#pragma unroll
            for (int i = 0; i < 8; ++i) {
                const int p = i * 16 + (tid >> 5);
                const u32x4 sv = *(const LAS u32x4*)(lds + CM_SO + p * CM_PS + c16 * 16);
                bf16_t* up = GU + (size_t)(row_base + p) * DM + ch;
                const u32x4 uv = *(const u32x4*)up;
                u32x4 w;
                w.x = pk2(bflo(uv.x) * bflo(sv.x), bfhi(uv.x) * bfhi(sv.x)); w.y = pk2(bflo(uv.y) * bflo(sv.y), bfhi(uv.y) * bfhi(sv.y));
                w.z = pk2(bflo(uv.z) * bflo(sv.z), bfhi(uv.z) * bfhi(sv.z)); w.w = pk2(bflo(uv.w) * bflo(sv.w), bfhi(uv.w) * bfhi(sv.w));
                *(u32x4*)up = w;
            }
        }
        __syncthreads();
    }
}
DI void p3a_dec(const Args& a, int vcu, int G, int wave, int lane) {
    unsigned char* ws = a.ws;
    const bf16_t* H = (const bf16_t*)(ws + WS_H); const float* win = a.in[I_WIN] + 5120; float* dec = (float*)(ws + WS_DEC);
    const int gw = vcu * NWAVES + wave, NGW = G * NWAVES, j = lane & 31, hh = lane >> 5;
    for (int it = NGW - 1 - gw; it < MT / 4; it += NGW) {
        const int r0 = it * 4 + hh * 2;
        const bf16_t* h0 = H + (size_t)r0 * DM; const bf16_t* h1 = h0 + DM;
        float a0 = 0.f, a1 = 0.f;
        for (int c = 0; c < DM; c += 8) {
            const u32x4 x0 = *(const u32x4*)(h0 + c), x1 = *(const u32x4*)(h1 + c);
            const float* wp = win + (size_t)c * WIN_PITCH + j;
            const float w0 = wp[0], w1 = wp[WIN_PITCH], w2 = wp[2 * WIN_PITCH], w3 = wp[3 * WIN_PITCH], w4 = wp[4 * WIN_PITCH], w5 = wp[5 * WIN_PITCH], w6 = wp[6 * WIN_PITCH], w7 = wp[7 * WIN_PITCH];
            a0 += bflo(x0.x) * w0 + bfhi(x0.x) * w1 + bflo(x0.y) * w2 + bfhi(x0.y) * w3 + bflo(x0.z) * w4 + bfhi(x0.z) * w5 + bflo(x0.w) * w6 + bfhi(x0.w) * w7;
            a1 += bflo(x1.x) * w0 + bfhi(x1.x) * w1 + bflo(x1.y) * w2 + bfhi(x1.y) * w3 + bflo(x1.z) * w4 + bfhi(x1.z) * w5 + bflo(x1.w) * w6 + bfhi(x1.w) * w7;
        }
        dec[(size_t)r0 * 32 + j] = a0; dec[(size_t)(r0 + 1) * 32 + j] = a1;
    }
}

constexpr int GP_K = 272, GP_V = 576, GP_A = 144;
constexpr int OS_P = 260;
constexpr int GL_QT = 0, GL_KT = GL_QT + 64 * GP_K, GL_VR = GL_KT + 64 * GP_K, GL_AT = GL_VR + 64 * GP_V, GL_DEC = GL_AT + 64 * GP_A, GL_GT = GL_DEC + 4096,
              GL_BL = GL_GT + 2048, GL_WD = GL_BL + 512, GL_OS = GL_WD + 8192, GL_OG = GL_OS + 64 * OS_P * 4, GL_END = GL_OG + 1024;
static_assert(GL_END <= LDSCTL_OFF, "GLA LDS map");
constexpr float L2E = 1.4426950408889634f;

struct GlaSrc { const bf16_t* q; const bf16_t* k; const bf16_t* v; const float* dec; };
struct GlaPref { u32x4 q0, q1, k0, k1, v0, v1, v2, v3; f32x4 d; };

template <bool FULL> DI void gla_issue(GlaPref& p, const GlaSrc& s, int tid_) {
    const int tid = opaque(tid_);
    { const int t = tid >> 4, c8 = (tid & 15) * 8;
      p.k0 = *(const u32x4*)(s.k + (size_t)t * 512 + c8); p.k1 = *(const u32x4*)(s.k + (size_t)(t + 32) * 512 + c8);
      if (FULL) { p.q0 = *(const u32x4*)(s.q + (size_t)t * 512 + c8); p.q1 = *(const u32x4*)(s.q + (size_t)(t + 32) * 512 + c8); } }
    { const int t = tid >> 5, c8 = (tid & 31) * 8; const bf16_t* vp = s.v + (size_t)t * 1024 + c8;
      p.v0 = *(const u32x4*)vp; p.v1 = *(const u32x4*)(vp + 16 * 1024); p.v2 = *(const u32x4*)(vp + 32 * 1024); p.v3 = *(const u32x4*)(vp + 48 * 1024); }
    if (tid < 256) p.d = *(const f32x4*)(s.dec + (size_t)(tid >> 2) * 32 + (tid & 3) * 4);
}
template <bool FULL> DI void gla_commit(LAS unsigned char* lds, const GlaPref& p, int tid_) {
    const int tid = opaque(tid_);
    { const int t = tid >> 4, cb = (tid & 15) * 16;
      *(LAS u32x4*)(lds + GL_KT + t * GP_K + cb) = p.k0; *(LAS u32x4*)(lds + GL_KT + (t + 32) * GP_K + cb) = p.k1;
      if (FULL) { *(LAS u32x4*)(lds + GL_QT + t * GP_K + cb) = p.q0; *(LAS u32x4*)(lds + GL_QT + (t + 32) * GP_K + cb) = p.q1; } }
    { const int t = tid >> 5, cb = (tid & 31) * 16;
      *(LAS u32x4*)(lds + GL_VR + t * GP_V + cb) = p.v0; *(LAS u32x4*)(lds + GL_VR + (t + 16) * GP_V + cb) = p.v1;
      *(LAS u32x4*)(lds + GL_VR + (t + 32) * GP_V + cb) = p.v2; *(LAS u32x4*)(lds + GL_VR + (t + 48) * GP_V + cb) = p.v3; }
    if (tid < 256) *(LAS f32x4*)(lds + GL_DEC + ((tid >> 2) * 16 + (tid & 3) * 4) * 4) = p.d;
}
DI void gla_load_wd(LAS unsigned char* lds, const float* wdp  , int tid_) {
    const int t4 = opaque(tid_) * 4, r = t4 >> 7, kd = t4 & 127;
    *(LAS f32x4*)(lds + GL_WD + t4 * 4) = *(const f32x4*)(wdp + (size_t)r * 512 + kd);
}
template <int DIR, bool FULL>
DI float gla_decay(LAS unsigned char* lds, float bd, int tid_) {
    int tid = opaque(tid_);
    const int kd = tid & 127, tg = tid >> 7;
    float c[16];
#pragma unroll
    for (int i = 0; i < 16; ++i) c[i] = bd;
#pragma unroll
    for (int r4 = 0; r4 < 4; ++r4) {
        const float w0 = *(const LAS float*)(lds + GL_WD + ((r4 * 4 + 0) * 128 + kd) * 4), w1 = *(const LAS float*)(lds + GL_WD + ((r4 * 4 + 1) * 128 + kd) * 4),
                    w2 = *(const LAS float*)(lds + GL_WD + ((r4 * 4 + 2) * 128 + kd) * 4), w3 = *(const LAS float*)(lds + GL_WD + ((r4 * 4 + 3) * 128 + kd) * 4);
#pragma unroll
        for (int i = 0; i < 16; ++i) { const f32x4 d = *(const LAS f32x4*)(lds + GL_DEC + ((tg * 16 + i) * 16 + r4 * 4) * 4); c[i] += d.x * w0 + d.y * w1 + d.z * w2 + d.w * w3; }
    }
#pragma unroll
    for (int i = 0; i < 16; ++i) {
        const float z = c[i], e = __builtin_amdgcn_exp2f(-L2E * fabsf(z));
        c[i] = (fminf(z, 0.f) - 0.6931471805599453f * __builtin_amdgcn_logf(1.f + e)) * (1.f / 16.f);
    }
    if (DIR == 0) {
#pragma unroll
        for (int i = 1; i < 16; ++i) c[i] += c[i - 1];
        *(LAS float*)(lds + GL_GT + (tg * 128 + kd) * 4) = c[15];
    } else {
#pragma unroll
        for (int i = 14; i >= 0; --i) c[i] += c[i + 1];
        *(LAS float*)(lds + GL_GT + (tg * 128 + kd) * 4) = c[0];
    }
    __syncthreads();
    float off = 0.f, total = 0.f;
#pragma unroll
    for (int g = 0; g < 4; ++g) { const float gt = *(const LAS float*)(lds + GL_GT + (g * 128 + kd) * 4); total += gt; if (DIR == 0 ? (g < tg) : (g > tg)) off += gt; }
#pragma unroll
    for (int i = 0; i < 16; ++i) {
        const int t = tg * 16 + i; const float b = c[i] + off;
        LAS bf16_t* kp = (LAS bf16_t*)(lds + GL_KT + t * GP_K + kd * 2);
        *kp = f2bf(bf2f(*kp) * __builtin_amdgcn_exp2f(-L2E * b));
        if (FULL) { LAS bf16_t* qp = (LAS bf16_t*)(lds + GL_QT + t * GP_K + kd * 2); *qp = f2bf(bf2f(*qp) * __builtin_amdgcn_exp2f(L2E * b)); }
    }
    if (tg == 0) *(LAS float*)(lds + GL_BL + kd * 4) = __builtin_amdgcn_exp2f(L2E * total);
    __syncthreads();
    return total;
}
DI void gla_update_state(f32x16 (&S)[4], const bf16x8 (&vf)[4], LAS unsigned char* lds, int lane) {
    const int h = lane >> 5;
#pragma unroll
    for (int m = 0; m < 4; ++m) {
#pragma unroll
        for (int ks = 0; ks < 4; ++ks) {
            const bf16x8 av = tr_frag(lds + GL_KT, GP_K, 16 * ks, 32 * m, lane);
            S[m] = __builtin_amdgcn_mfma_f32_32x32x16_bf16(av, vf[ks], S[m], 0, 0, 0);
        }
#pragma unroll
        for (int g = 0; g < 4; ++g) {
            const f32x4 gm = *(const LAS f32x4*)(lds + GL_BL + (m * 32 + 8 * g + 4 * h) * 4);
            S[m][4 * g] *= gm.x; S[m][4 * g + 1] *= gm.y; S[m][4 * g + 2] *= gm.z; S[m][4 * g + 3] *= gm.w;
        }
    }
}
DI bf16x8 pack_step(const f32x16& x, int s) {
    u32x4 p; p.x = pk2(x[8 * s], x[8 * s + 1]); p.y = pk2(x[8 * s + 2], x[8 * s + 3]); p.z = pk2(x[8 * s + 4], x[8 * s + 5]); p.w = pk2(x[8 * s + 6], x[8 * s + 7]);
    return __builtin_bit_cast(bf16x8, p);
}
constexpr int GP_S = 528, GL_SS = 0, GL_SL = GL_OS;
static_assert(128 * GP_S <= GL_AT && GL_OS + 128 * GP_S <= GL_END, "state staging");
DI void gla_store_state(const f32x16 (&S)[4], bf16_t* stp, LAS unsigned char* lds, int wave, int lane_, int tid_) {
    {   const int lane = opaque(lane_), n = wave * 32 + (lane & 31), h = lane >> 5;
#pragma unroll
        for (int m = 0; m < 4; ++m)
#pragma unroll
            for (int r = 0; r < 16; ++r) *(LAS bf16_t*)(lds + GL_SS + (m * 32 + crow(r, h)) * GP_S + n * 2) = f2bf(S[m][r]); }
    __syncthreads();
    {   const int tid = opaque(tid_), c16 = tid & 31, r0 = tid >> 5;
#pragma unroll
        for (int i = 0; i < 8; ++i) { const int row = i * 16 + r0; *(u32x4*)(stp + (size_t)row * 256 + c16 * 8) = *(const LAS u32x4*)(lds + GL_SS + row * GP_S + c16 * 16); } }
    __syncthreads();
}
DI void gla_load_state(f32x16 (&S)[4], const bf16_t* stp, LAS unsigned char* lds, int wave, int lane_, int tid_) {
    {   const int tid = opaque(tid_), c16 = tid & 31, r0 = tid >> 5;
#pragma unroll
        for (int hh = 0; hh < 2; ++hh) {
            u32x4 v[4];
#pragma unroll
            for (int i = 0; i < 4; ++i) v[i] = *(const u32x4*)(stp + (size_t)((hh * 4 + i) * 16 + r0) * 256 + c16 * 8);
#pragma unroll
            for (int i = 0; i < 4; ++i) *(LAS u32x4*)(lds + GL_SL + ((hh * 4 + i) * 16 + r0) * GP_S + c16 * 16) = v[i];
        } }
    __syncthreads();
    {   const int lane = opaque(lane_), n = wave * 32 + (lane & 31), h = lane >> 5;
#pragma unroll
        for (int m = 0; m < 4; ++m)
#pragma unroll
            for (int r = 0; r < 16; ++r) S[m][r] = bf2f(*(const LAS bf16_t*)(lds + GL_SL + (m * 32 + crow(r, h)) * GP_S + n * 2)); }
    __syncthreads();
}
DI GlaSrc gla_src1(unsigned char* ws, int item, int cc) {
    const int chain = item >> 5, slot = item & 31, b = chain >> 3, hd = (chain >> 1) & 3, dir = chain & 1, c = dir == 0 ? cc : 3 - cc;
    GlaSrc s; s.q = nullptr;
    if (slot == 0) { const size_t r = (size_t)(b * CTXL + c * 64);
        s.k = (const bf16_t*)(ws + WS_KC) + r * 512 + hd * 128; s.v = (const bf16_t*)(ws + WS_VC) + r * 1024 + hd * 256; s.dec = (const float*)(ws + WS_DEC) + ((size_t)M + r) * 32 + dir * 16; }
    else { const int j = dir == 0 ? slot - 1 : 32 - slot; const size_t r = (size_t)b * SEQ + (size_t)j * 256 + c * 64;
        s.k = (const bf16_t*)(ws + WS_K) + r * 512 + hd * 128; s.v = (const bf16_t*)(ws + WS_V) + r * 1024 + hd * 256; s.dec = (const float*)(ws + WS_DEC) + r * 32 + dir * 16; }
    return s;
}
template <int DIR>
DI void gla_pass1_dir(const Args& a, LAS unsigned char* lds, int first, int G, int nitems, int wave, int lane, int tid) {
    unsigned char* ws = a.ws;
    GlaPref pf;
    gla_issue<false>(pf, gla_src1(ws, first, 0), tid);
    f32x16 S[4]; float gtot = 0.f, bd = 0.f;
#pragma unroll 1
    for (int st = 0; st < nitems * 4; ++st) {
        const int item = first + (st >> 2) * G, cc = st & 3, chain = item >> 5, slot = item & 31, hd = (chain >> 1) & 3;
        if (cc == 0) {
            gla_load_wd(lds, a.in[I_WDEC2] + (size_t)DIR * 16 * 512 + hd * 128, tid);
            bd = a.in[I_BDEC][DIR * 512 + hd * 128 + (tid & 127)];
#pragma unroll
            for (int m = 0; m < 4; ++m) for (int e = 0; e < 16; ++e) S[m][e] = 0.f;
            gtot = 0.f;
        }
        gla_commit<false>(lds, pf, tid);
        if (st + 1 < nitems * 4) gla_issue<false>(pf, gla_src1(ws, first + ((st + 1) >> 2) * G, (st + 1) & 3), tid);
        __syncthreads();
        gtot += gla_decay<DIR, false>(lds, bd, tid);
        bf16x8 vf[4];
#pragma unroll
        for (int ks = 0; ks < 4; ++ks) vf[ks] = tr_frag(lds + GL_VR, GP_V, 16 * ks, wave * 32, opaque(lane));
        gla_update_state(S, vf, lds, opaque(lane));
        __syncthreads();
        if (cc == 3) {
            gla_store_state(S, (bf16_t*)(ws + WS_ST) + ((size_t)chain * 33 + slot) * 32768, lds, wave, lane, tid);
            if (tid < 128) ((float*)(ws + WS_GAM))[((size_t)chain * 33 + slot) * 128 + tid] = __builtin_amdgcn_exp2f(L2E * gtot);
        }
    }
}
DI void gla_pass1(const Args& a, LAS unsigned char* lds, int vcu, int G, int wave, int lane, int tid) {
    const int nitems = (16 * NSC - vcu + G - 1) / G;
    if (nitems <= 0) return;
    if ((G & 63) == 0) {
        if (((vcu >> 5) & 1) == 0) gla_pass1_dir<0>(a, lds, vcu, G, nitems, wave, lane, tid); else gla_pass1_dir<1>(a, lds, vcu, G, nitems, wave, lane, tid);
    } else {
        for (int item = vcu; item < 16 * NSC; item += G) {
            if (((item >> 5) & 1) == 0) gla_pass1_dir<0>(a, lds, item, G, 1, wave, lane, tid); else gla_pass1_dir<1>(a, lds, item, G, 1, wave, lane, tid);
        }
    }
}
DI void gla_pass2(const Args& a, int vcu, int G, int tid) {
    unsigned char* ws = a.ws;
    const float* gam = (const float*)(ws + WS_GAM);
    for (int e = vcu * NTHR + tid; e < 16 * 128 * 64; e += G * NTHR) {
        const int chain = e >> 13, kd = (e >> 6) & 127, n4 = e & 63;
        u32x2* st = (u32x2*)((bf16_t*)(ws + WS_ST) + (size_t)chain * 33 * 32768 + (size_t)kd * 256 + n4 * 4);
        float s0 = 0.f, s1 = 0.f, s2 = 0.f, s3 = 0.f;
        u32x2 d = st[0];
        for (int slot = 0; slot < 32; ++slot) {
            const float gm = gam[((size_t)chain * 33 + slot) * 128 + kd];
            const u32x2 dn = (slot < 31) ? st[(size_t)(slot + 1) * 8192] : d;
            if (slot > 0) st[(size_t)slot * 8192] = (u32x2){pk2(s0, s1), pk2(s2, s3)};
            s0 = gm * s0 + bflo(d.x); s1 = gm * s1 + bfhi(d.x); s2 = gm * s2 + bflo(d.y); s3 = gm * s3 + bfhi(d.y);
            d = dn;
        }
        st[(size_t)32 * 8192] = (u32x2){pk2(s0, s1), pk2(s2, s3)};
    }
}
template <int DIR>
DI void gla_chunk_out(f32x16 (&S)[4], LAS unsigned char* lds, int wave, int lane_) {
    int lane = opaque(lane_);
    int r = lane & 31, h = lane >> 5;
    if (wave < 4) {
        const int ti = wave >> 1, tj = wave & 1;
        f32x16 at; for (int e = 0; e < 16; ++e) at[e] = 0.f;
#pragma unroll
        for (int ks = 0; ks < 8; ++ks) {
            const bf16x8 av = *(const LAS bf16x8*)(lds + GL_QT + (ti * 32 + r) * GP_K + (16 * ks + 8 * h) * 2);
            const bf16x8 bv = *(const LAS bf16x8*)(lds + GL_KT + (tj * 32 + r) * GP_K + (16 * ks + 8 * h) * 2);
            at = __builtin_amdgcn_mfma_f32_32x32x16_bf16(av, bv, at, 0, 0, 0);
        }
        const int j = tj * 32 + r;
#pragma unroll
        for (int e = 0; e < 16; ++e) {
            const int i = ti * 32 + crow(e, h);
            const bool keep = DIR == 0 ? (j <= i) : (j >= i);
            *(LAS bf16_t*)(lds + GL_AT + i * GP_A + j * 2) = f2bf(keep ? at[e] : 0.f);
        }
    }
    bf16x8 vf[4];
#pragma unroll
    for (int ks = 0; ks < 4; ++ks) vf[ks] = tr_frag(lds + GL_VR, GP_V, 16 * ks, wave * 32, lane);
    __syncthreads();
#pragma unroll
    for (int ti = 0; ti < 2; ++ti) {
        f32x16 o; for (int e = 0; e < 16; ++e) o[e] = 0.f;
#pragma unroll
        for (int ks = 0; ks < 4; ++ks) {
            const bf16x8 av = *(const LAS bf16x8*)(lds + GL_AT + (ti * 32 + r) * GP_A + (16 * ks + 8 * h) * 2);
            o = __builtin_amdgcn_mfma_f32_32x32x16_bf16(av, vf[ks], o, 0, 0, 0);
        }
#pragma unroll
        for (int m = 0; m < 4; ++m)
#pragma unroll
            for (int s = 0; s < 2; ++s) {
                const bf16x8 bs = pack_step(S[m], s);
                const LAS unsigned char* qp = lds + GL_QT + (ti * 32 + r) * GP_K + (m * 32 + 16 * s + 4 * h) * 2;
                const s16x4 lo = *(const LAS s16x4*)qp, hi = *(const LAS s16x4*)(qp + 16);
                const bf16x8 av = __builtin_shufflevector(lo, hi, 0, 1, 2, 3, 4, 5, 6, 7);
                o = __builtin_amdgcn_mfma_f32_32x32x16_bf16(av, bs, o, 0, 0, 0);
            }
        const int n = wave * 32 + r;
#pragma unroll
        for (int e = 0; e < 16; ++e) *(LAS float*)(lds + GL_OS + ((ti * 32 + crow(e, h)) * OS_P + n) * 4) = o[e];
        __builtin_amdgcn_sched_barrier(0);
    }
    gla_update_state(S, vf, lds, lane);
    __syncthreads();
}
DI GlaSrc gla_src3(unsigned char* ws, size_t r0, int hd, int s) {
    const int dir = s >> 2, cc = s & 3, c = dir ? 3 - cc : cc; const size_t rc = r0 + (size_t)c * 64;
    GlaSrc g; g.q = (const bf16_t*)(ws + WS_Q) + rc * 512 + hd * 128; g.k = (const bf16_t*)(ws + WS_K) + rc * 512 + hd * 128;
    g.v = (const bf16_t*)(ws + WS_V) + rc * 1024 + hd * 256; g.dec = (const float*)(ws + WS_DEC) + rc * 32 + dir * 16;
    return g;
}
template <int DIR>
DI void gla_pass3_dir(const Args& a, LAS unsigned char* lds, GlaPref& pf, int b, int hd, int j, int wave, int lane, int tid) {
    unsigned char* ws = a.ws;
    const size_t r0 = (size_t)b * SEQ + (size_t)j * 256;
    const int chain = (b * 4 + hd) * 2 + DIR;
    f32x16 S[4];
    gla_commit<true>(lds, pf, tid);
    __syncthreads();
    gla_load_state(S, (const bf16_t*)(ws + WS_ST) + ((size_t)chain * 33 + (DIR == 0 ? j + 1 : 32 - j)) * 32768, lds, wave, lane, tid);
    { const int t_ = opaque(tid); if (t_ < 64) *(LAS f32x4*)(lds + GL_OG + t_ * 16) = *(const f32x4*)(a.in[I_ONG] + hd * 256 + t_ * 4); }
    gla_load_wd(lds, a.in[I_WDEC2] + (size_t)DIR * 16 * 512 + hd * 128, tid);
    const float bd = a.in[I_BDEC][DIR * 512 + hd * 128 + (tid & 127)];
#pragma unroll 1
    for (int cc = 0; cc < 4; ++cc) {
        const int s = DIR * 4 + cc, c = DIR ? 3 - cc : cc;
        const size_t rc = r0 + (size_t)c * 64;
        if (cc > 0) gla_commit<true>(lds, pf, tid);
        __syncthreads();
        gla_decay<DIR, true>(lds, bd, tid);
        const int tid2 = opaque(tid), row = tid2 >> 3, seg = tid2 & 7;
        bf16_t* ofp = (bf16_t*)(ws + WS_OF) + (rc + row) * 1024 + hd * 256 + seg * 32;
        bf16_t* rp = (bf16_t*)(ws + WS_R) + (rc + row) * 1024 + hd * 256 + seg * 32;
        u32x4 fo[4];
        if (DIR == 1) {
#pragma unroll
            for (int q8 = 0; q8 < 4; ++q8) fo[q8] = *(const u32x4*)(ofp + q8 * 8);
        }
        gla_chunk_out<DIR>(S, lds, wave, lane);
        if (s < 7) gla_issue<true>(pf, gla_src3(ws, r0, hd, s + 1), tid);
        const LAS unsigned char* osp = lds + GL_OS + (row * OS_P + seg * 32) * 4;
        if (DIR == 0) {
#pragma unroll
            for (int q8 = 0; q8 < 4; ++q8) { const f32x4 x0 = *(const LAS f32x4*)(osp + q8 * 32), x1 = *(const LAS f32x4*)(osp + q8 * 32 + 16);
                u32x4 w; w.x = pk2(x0.x, x0.y); w.y = pk2(x0.z, x0.w); w.z = pk2(x1.x, x1.y); w.w = pk2(x1.z, x1.w); *(u32x4*)(ofp + q8 * 8) = w; }
        } else {
            float ov[32]; float ss = 0.f;
#pragma unroll
            for (int q8 = 0; q8 < 4; ++q8) { const f32x4 x0 = *(const LAS f32x4*)(osp + q8 * 32), x1 = *(const LAS f32x4*)(osp + q8 * 32 + 16); const u32x4 w = fo[q8];
                ov[q8 * 8] = x0.x + bflo(w.x); ov[q8 * 8 + 1] = x0.y + bfhi(w.x); ov[q8 * 8 + 2] = x0.z + bflo(w.y); ov[q8 * 8 + 3] = x0.w + bfhi(w.y);
                ov[q8 * 8 + 4] = x1.x + bflo(w.z); ov[q8 * 8 + 5] = x1.y + bfhi(w.z); ov[q8 * 8 + 6] = x1.z + bflo(w.w); ov[q8 * 8 + 7] = x1.w + bfhi(w.w); }
#pragma unroll
            for (int e = 0; e < 32; ++e) ss += ov[e] * ov[e];
            ss += __shfl_xor(ss, 1); ss += __shfl_xor(ss, 2); ss += __shfl_xor(ss, 4);
            const float rs = rsqrtf(ss * (1.f / 256.f) + EPS);
            const LAS unsigned char* gp = lds + GL_OG + seg * 128;
#pragma unroll
            for (int q8 = 0; q8 < 4; ++q8) {
                const u32x4 rw = *(const u32x4*)(rp + q8 * 8); const f32x4 g0 = *(const LAS f32x4*)(gp + q8 * 32), g1 = *(const LAS f32x4*)(gp + q8 * 32 + 16);
                u32x4 w;
                w.x = pk2(ov[q8 * 8] * rs * g0.x * bflo(rw.x), ov[q8 * 8 + 1] * rs * g0.y * bfhi(rw.x)); w.y = pk2(ov[q8 * 8 + 2] * rs * g0.z * bflo(rw.y), ov[q8 * 8 + 3] * rs * g0.w * bfhi(rw.y));
                w.z = pk2(ov[q8 * 8 + 4] * rs * g1.x * bflo(rw.z), ov[q8 * 8 + 5] * rs * g1.y * bfhi(rw.z)); w.w = pk2(ov[q8 * 8 + 6] * rs * g1.z * bflo(rw.w), ov[q8 * 8 + 7] * rs * g1.w * bfhi(rw.w));
                *(u32x4*)(rp + q8 * 8) = w;
            }
        }
    }
}
DI void gla_pass3(const Args& a, LAS unsigned char* lds, int vcu, int G, int wave, int lane, int tid) {
    unsigned char* ws = a.ws;
    for (int item = vcu; item < 8 * NSC; item += G) {
        const int b = item >> 7, hd = (item >> 5) & 3, j = item & 31;
        GlaPref pf;
        gla_issue<true>(pf, gla_src3(ws, (size_t)b * SEQ + (size_t)j * 256, hd, 0), tid);
        gla_pass3_dir<0>(a, lds, pf, b, hd, j, wave, lane, tid);
        VM_WAIT();
        gla_pass3_dir<1>(a, lds, pf, b, hd, j, wave, lane, tid);
        __syncthreads();
    }
}

__global__ void __launch_bounds__(NTHR, 2) fwd_kernel(Args args) {
    extern __shared__ __attribute__((aligned(16))) unsigned char lds_raw[];
    LAS unsigned char* lds = (LAS unsigned char*)lds_raw;
    volatile LAS unsigned* MISC = (volatile LAS unsigned*)(lds + MISC_OFF);
    const int tid = threadIdx.x, lane = tid & 63, wave = __builtin_amdgcn_readfirstlane(tid >> 6);
    const int G = gridDim.x; const int bx = blockIdx.x; const int vcu = (G % 8 == 0) ? (bx % 8) * (G / 8) + bx / 8 : bx;
    unsigned char* ws = args.ws;
    for (int u = tid; u < (LDS_BYTES - LDSCTL_OFF) / 4; u += NTHR) ((LAS unsigned*)(lds + LDSCTL_OFF))[u] = 0u;
    __syncthreads();
    XcdBarrier bar = xcd_barrier_post((unsigned*)(ws + WS_CTL) + CW_BAR, MISC + 8);
#define GRID_BAR() xcd_barrier(bar)
    unsigned long long tA_ = 0, tB_ = 0;
#define STAMP(k) do { if (STAMP_A == (k)) tA_ = __builtin_amdgcn_s_memrealtime(); if (STAMP_B == (k)) tB_ = __builtin_amdgcn_s_memrealtime(); } while (0)
    STAMP(0);

    REP(0) p0_prologue(args, lds, vcu, G, wave, opaque(tid) & 63);
    GRID_BAR(); STAMP(1);
    REP(1) { const int t_ = opaque(tid); p1_rows(args, lds, vcu, G, wave, t_ & 63, t_); __syncthreads(); }
    GRID_BAR(); STAMP(2);
    {
        pg8::Gemm g; g.A0 = (const bf16_t*)(ws + WS_H); g.A1 = (const bf16_t*)(ws + WS_H) + (size_t)M * DM; g.B0 = g.B1 = (const bf16_t*)(ws + WS_WIN); g.lda = DM; g.ldb = DM; g.K = DM;
        SchedP2 S{G, bx}; EpiZ E{ws, (bf16_t*)args.out};
        REP(2) pg8::gemm_phase<EpiZ, SchedP2, true>(lds, g, S, E);
    }
    GRID_BAR(); STAMP(3);
    REP(3) { const int t_ = opaque(tid); p3a_chunk_mlp(args, lds, vcu, G, wave, t_ & 63, t_); }
    GRID_BAR(); STAMP(4);
    REP(5) { const int t_ = opaque(tid); gla_pass1(args, lds, vcu, G, wave, t_ & 63, t_); }
    GRID_BAR(); STAMP(5);
    REP(6) gla_pass2(args, vcu, G, opaque(tid));
    GRID_BAR(); STAMP(6);
    REP(7) { const int t_ = opaque(tid); gla_pass3(args, lds, vcu, G, wave, t_ & 63, t_); }
    GRID_BAR(); STAMP(7);
    {
        pg8::Gemm g; g.A0 = (const bf16_t*)(ws + WS_GU); g.A1 = (const bf16_t*)(ws + WS_R); g.B0 = (const bf16_t*)(ws + WS_PA); g.B1 = (const bf16_t*)(ws + WS_PB); g.lda = DM; g.ldb = DM; g.K = DM;
        SchedMerge S{G, bx}; EpiMerge E{(bf16_t*)(ws + WS_MG), (const bf16_t*)args.out};
        REP(8) pg8::gemm_phase<EpiMerge, SchedMerge, true>(lds, g, S, E);
    }
    GRID_BAR(); STAMP(8);
    {
        pg8::Gemm g; g.A0 = g.A1 = (const bf16_t*)(ws + WS_MG); g.B0 = g.B1 = (const bf16_t*)(ws + WS_WO); g.lda = DM; g.ldb = DM; g.K = DM;
        pg8::StaticOrder S; S.init(M, DM, G, bx); EpiRes1 E{args.in[I_X], (const float*)(ws + WS_POS), (const float*)(ws + WS_MODF), args.out};
        REP(9) pg8::gemm_phase<EpiRes1, pg8::StaticOrder, false>(lds, g, S, E);
    }
    GRID_BAR(); STAMP(9);
    REP(10) p5c_rows(args, vcu, G, wave, opaque(tid) & 63);
    GRID_BAR(); STAMP(10);
    {
        pg8::Gemm g; g.A0 = g.A1 = (const bf16_t*)(ws + WS_H); g.B0 = g.B1 = (const bf16_t*)(ws + WS_W1); g.lda = DM; g.ldb = DM; g.K = DM;
        pg8::StaticOrder S; S.init(M, DFF, G, bx); EpiFF1 E{(bf16_t*)(ws + WS_T)};
        REP(11) pg8::gemm_phase<EpiFF1, pg8::StaticOrder, true>(lds, g, S, E);
    }
    GRID_BAR(); STAMP(11);
    {
        pg8::Gemm g; g.A0 = g.A1 = (const bf16_t*)(ws + WS_T); g.B0 = g.B1 = (const bf16_t*)(ws + WS_W2); g.lda = DFF; g.ldb = DFF; g.K = DFF;
        pg8::StaticOrder S; S.init(M, DM, G, bx); EpiRes2 E{(const float*)(ws + WS_MODF), args.out};
        REP(12) pg8::gemm_phase<EpiRes2, pg8::StaticOrder, false>(lds, g, S, E);
    }
    GRID_BAR(); STAMP(12);
    REP(13) p7_rows(args, vcu, G, wave, opaque(tid) & 63);
    if (STAMP_A >= 0) { STAMP(13); VM_WAIT(); __syncthreads(); if (bx == 0 && tid == 0) args.out[0] += (float)(tB_ - tA_) * 0.001f; }
}

extern "C" void kernel_launch(void* const* d_in, const int* in_sizes, int n_in, void* d_out, int out_size, void* d_ws, size_t ws_size, hipStream_t stream) {
    static int grid = 0;
    if (grid == 0) {
        if (n_in != 22 || out_size != M * DM || ws_size < WS_END) { fprintf(stderr, "kernel_launch: unexpected shapes (n_in %d out %d ws %zu)\n", n_in, out_size, ws_size); grid = -1; return; }
        int dev = 0, cus = 0, per_cu = 0;
        if (hipGetDevice(&dev) != hipSuccess || hipDeviceGetAttribute(&cus, hipDeviceAttributeMultiprocessorCount, dev) != hipSuccess) { grid = -1; return; }
        if (hipFuncSetAttribute((const void*)fwd_kernel, hipFuncAttributeMaxDynamicSharedMemorySize, LDS_BYTES) != hipSuccess) { fprintf(stderr, "kernel_launch: hipFuncSetAttribute failed\n"); grid = -1; return; }
        if (hipOccupancyMaxActiveBlocksPerMultiprocessor(&per_cu, (const void*)fwd_kernel, NTHR, LDS_BYTES) != hipSuccess || per_cu < 1) { fprintf(stderr, "kernel_launch: occupancy query says %d\n", per_cu); (void)hipGetLastError(); per_cu = 1; }
        grid = cus;
    }
    if (grid < 0) return;
    (void)hipMemsetAsync((char*)d_ws + WS_CTL, 0, CTL_ZERO_BYTES, stream);
    Args a{};
    for (int i = 0; i < 22; ++i) a.in[i] = (const float*)d_in[i];
    a.out = (float*)d_out; a.ws = (unsigned char*)d_ws;
    hipLaunchKernelGGL(fwd_kernel, dim3(grid), dim3(NTHR), LDS_BYTES, stream, a);
}
```
